# Optimizing an MI355X kernel written in HIP

```python
import math
import jax, jax.numpy as jnp
from jax import lax
import numpy as np

D_MODEL = 1024
BATCH = 2
SEQ = 8192
DEPTH = 4

N_MIXERS = 2
BLK = 128
ROPE_THETA = 500000.0
EPS = 1e-6
NEG_INF = -1e30

DILATED_GROUPS = ((128, 1), (512, 4), (2048, 16))
A_N_GROUPS = len(DILATED_GROUPS)
A_HEAD_DIM = 128
A_HEADS = D_MODEL // A_HEAD_DIM
A_WIDTH = A_HEADS * A_HEAD_DIM
A_ROT = A_HEAD_DIM // 4
A_QKV = 3 * A_N_GROUPS * A_WIDTH
A_IN = A_QKV + A_WIDTH

B_HEADS = 8
B_HEAD_DIM = 64
B_WIDTH = B_HEADS * 2 * B_HEAD_DIM
B_ROT = B_HEAD_DIM // 4
B_IN = 4 * B_WIDTH

N_A_LAYERS = (DEPTH + 1) // 2
N_B_LAYERS = DEPTH // 2

kernel_name = "hybrid_dilated_diff_gated_trunk"


def rms_norm(x, g):
    xf = x.astype(jnp.float32)
    y = xf * lax.rsqrt(jnp.mean(xf * xf, axis=-1, keepdims=True) + EPS)
    return (y * g.astype(jnp.float32)).astype(x.dtype)


def rope_tables(seq, rot_dim):
    inv = 1.0 / (ROPE_THETA ** (jnp.arange(0, rot_dim, 2, dtype=jnp.float32) / rot_dim))
    ang = jnp.arange(seq, dtype=jnp.float32)[:, None] * inv[None, :]
    return jnp.cos(ang), jnp.sin(ang)


def apply_partial_rope(x, cos, sin):
    half = cos.shape[-1]
    x1, x2, xp = x[..., :half], x[..., half:2 * half], x[..., 2 * half:]
    c = cos[None, :, None, :].astype(x.dtype)
    s = sin[None, :, None, :].astype(x.dtype)
    return jnp.concatenate([x1 * c - x2 * s, x2 * c + x1 * s, xp], axis=-1)


def shift_blocks(t, j):
    nb = t.shape[2]
    return jnp.pad(t, ((0, 0), (0, 0), (j, 0), (0, 0), (0, 0), (0, 0)))[:, :, :nb]


def dilated_group_attention(q, k, v, window, dilation):
    b, s, h, d = q.shape
    r = dilation
    w_sub = window // dilation
    n_prev = -(-w_sub // BLK)
    seg = r * BLK
    s_pad = -(-s // seg) * seg
    L = s_pad // r
    nb = L // BLK

    def to_blocks(t):
        t = jnp.pad(t, ((0, 0), (0, s_pad - s), (0, 0), (0, 0)))
        t = t.reshape(b, L, r, h, d).transpose(0, 2, 1, 3, 4)
        return t.reshape(b, r, nb, BLK, h, d)

    qb, kb, vb = to_blocks(q), to_blocks(k), to_blocks(v)
    kc = jnp.concatenate([shift_blocks(kb, j) for j in range(n_prev, 0, -1)] + [kb], axis=3)
    vc = jnp.concatenate([shift_blocks(vb, j) for j in range(n_prev, 0, -1)] + [vb], axis=3)

    scores = jnp.einsum('brnqhd,brnkhd->brnhqk', qb, kc,
                        preferred_element_type=jnp.float32) * (d ** -0.5)
    n_keys = (n_prev + 1) * BLK
    qi = jnp.arange(BLK)[:, None]
    ki = jnp.arange(n_keys)[None, :]
    dist = qi + n_prev * BLK - ki
    band = (dist >= 0) & (dist <= w_sub)
    kvalid = (jnp.arange(nb)[:, None] * BLK - n_prev * BLK + ki) >= 0
    mask = band[None, :, :] & kvalid[:, None, :]
    scores = jnp.where(mask[None, None, :, None, :, :], scores, NEG_INF)
    lse = jax.nn.logsumexp(scores, axis=-1)
    p = jnp.exp(scores - lse[..., None]).astype(v.dtype)
    o = jnp.einsum('brnhqk,brnkhd->brnqhd', p, vc)

    o = o.reshape(b, r, L, h, d).transpose(0, 2, 1, 3, 4).reshape(b, s_pad, h, d)[:, :s]
    lse = lse.transpose(0, 1, 2, 4, 3).reshape(b, r, L, h).transpose(0, 2, 1, 3)
    lse = lse.reshape(b, s_pad, h)[:, :s]
    return o, lse


def dilated_mixer(hn, w_in, w_out, cos, sin):
    b, s, _ = hn.shape
    proj = hn @ w_in
    qkv = proj[..., :A_QKV].reshape(b, s, A_N_GROUPS, 3, A_HEADS, A_HEAD_DIM)
    z = proj[..., A_QKV:]
    outs, lses = [], []
    for g, (window, dilation) in enumerate(DILATED_GROUPS):
        q = apply_partial_rope(qkv[:, :, g, 0], cos, sin)
        k = apply_partial_rope(qkv[:, :, g, 1], cos, sin)
        v = qkv[:, :, g, 2]
        o, l = dilated_group_attention(q, k, v, window, dilation)
        outs.append(o)
        lses.append(l)
    alpha = jax.nn.softmax(jnp.stack(lses, axis=0), axis=0)
    o = jnp.einsum('gbsh,gbshd->bshd', alpha.astype(outs[0].dtype), jnp.stack(outs, axis=0))
    y = o.reshape(b, s, A_WIDTH) * jax.nn.silu(z)
    return y @ w_out


def diff_mixer(hn, w_in, lam_params, subln, w_out, cos, sin, lam_init):
    b, s, _ = hn.shape
    proj = hn @ w_in
    q = proj[..., :B_WIDTH].reshape(b, s, B_HEADS, 2, B_HEAD_DIM)
    k = proj[..., B_WIDTH:2 * B_WIDTH].reshape(b, s, B_HEADS, 2, B_HEAD_DIM)
    v = proj[..., 2 * B_WIDTH:3 * B_WIDTH].reshape(b, s, B_HEADS, 2 * B_HEAD_DIM)
    z = proj[..., 3 * B_WIDTH:]
    q1 = apply_partial_rope(q[..., 0, :], cos, sin)
    q2 = apply_partial_rope(q[..., 1, :], cos, sin)
    k1 = apply_partial_rope(k[..., 0, :], cos, sin)
    k2 = apply_partial_rope(k[..., 1, :], cos, sin)

    lp = lam_params.astype(jnp.float32)
    lam = jnp.exp(jnp.sum(lp[0] * lp[1])) - jnp.exp(jnp.sum(lp[2] * lp[3])) + lam_init

    nb = s // BLK
    qb1 = q1.reshape(b, nb, BLK, B_HEADS, B_HEAD_DIM).transpose(1, 0, 2, 3, 4)
    qb2 = q2.reshape(b, nb, BLK, B_HEADS, B_HEAD_DIM).transpose(1, 0, 2, 3, 4)
    kpos = jnp.arange(s)
    scale = B_HEAD_DIM ** -0.5

    def block(args):
        i, a1, a2 = args
        qpos = i * BLK + jnp.arange(BLK)
        causal = (kpos[None, :] <= qpos[:, None])[None, None]
        s1 = jnp.einsum('bqhd,bkhd->bhqk', a1, k1, preferred_element_type=jnp.float32) * scale
        s2 = jnp.einsum('bqhd,bkhd->bhqk', a2, k2, preferred_element_type=jnp.float32) * scale
        p1 = jax.nn.softmax(jnp.where(causal, s1, NEG_INF), axis=-1)
        p2 = jax.nn.softmax(jnp.where(causal, s2, NEG_INF), axis=-1)
        a = (p1 - lam * p2).astype(v.dtype)
        return jnp.einsum('bhqk,bkhe->bqhe', a, v)

    o = lax.map(block, (jnp.arange(nb), qb1, qb2))
    o = o.transpose(1, 0, 2, 3, 4).reshape(b, s, B_HEADS, 2 * B_HEAD_DIM)
    o = rms_norm(o, subln) * (1.0 - lam_init)
    y = o.reshape(b, s, B_WIDTH) * jax.nn.silu(z)
    return y @ w_out


def setup_inputs(seed: int = 0) -> dict:
    key = jax.random.key(seed)
    ks = jax.random.split(key, 10)
    f32 = jnp.float32
    x = jax.random.normal(ks[0], (BATCH, SEQ, D_MODEL), f32)
    a_norm = 1.0 + 0.02 * jax.random.normal(ks[1], (N_A_LAYERS, D_MODEL), f32)
    a_w_in = jax.random.normal(ks[2], (N_A_LAYERS, D_MODEL, A_IN), f32) * D_MODEL ** -0.5
    a_w_out = jax.random.normal(ks[3], (N_A_LAYERS, A_WIDTH, D_MODEL), f32) * A_WIDTH ** -0.5
    b_norm = 1.0 + 0.02 * jax.random.normal(ks[4], (N_B_LAYERS, D_MODEL), f32)
    b_w_in = jax.random.normal(ks[5], (N_B_LAYERS, D_MODEL, B_IN), f32) * D_MODEL ** -0.5
    b_lambda = 0.1 * jax.random.normal(ks[6], (N_B_LAYERS, 4, B_HEAD_DIM), f32)
    b_subln = 1.0 + 0.02 * jax.random.normal(ks[7], (N_B_LAYERS, 2 * B_HEAD_DIM), f32)
    b_w_out = jax.random.normal(ks[8], (N_B_LAYERS, B_WIDTH, D_MODEL), f32) * B_WIDTH ** -0.5
    final_norm = 1.0 + 0.02 * jax.random.normal(ks[9], (D_MODEL,), f32)
    return {"x": x, "a_norm": a_norm, "a_w_in": a_w_in, "a_w_out": a_w_out,
            "b_norm": b_norm, "b_w_in": b_w_in, "b_lambda": b_lambda,
            "b_subln": b_subln, "b_w_out": b_w_out, "final_norm": final_norm}


def reference(x, a_norm, a_w_in, a_w_out, b_norm, b_w_in, b_lambda, b_subln, b_w_out, final_norm):
    s = x.shape[1]
    cos_a, sin_a = rope_tables(s, A_ROT)
    cos_b, sin_b = rope_tables(s, B_ROT)
    for i in range(DEPTH):
        j = i // N_MIXERS
        if i % N_MIXERS == 0:
            x = x + dilated_mixer(rms_norm(x, a_norm[j]), a_w_in[j], a_w_out[j], cos_a, sin_a)
        else:
            lam_init = 0.8 - 0.6 * math.exp(-0.3 * i)
            x = x + diff_mixer(rms_norm(x, b_norm[j]), b_w_in[j], b_lambda[j], b_subln[j],
                               b_w_out[j], cos_b, sin_b, lam_init)
    return rms_norm(x, final_norm)
```

```cpp
#include <hip/hip_runtime.h>
#include <hip/hip_cooperative_groups.h>
#include <cstdio>
#include <cstdint>
namespace cg = cooperative_groups;
namespace pg8 {
#define PG8_LAS __attribute__((address_space(3)))
typedef unsigned short bf16_t;
typedef short bf16x8 __attribute__((ext_vector_type(8)));
typedef float f32x4 __attribute__((ext_vector_type(4)));
typedef unsigned u32x4 __attribute__((ext_vector_type(4)));
constexpr int BM = 256, BK = 64, HALF = 128, HTB = HALF * BK * 2  , STAGE_BYTES = 8 * HTB, NXCD = 8, WGM = 8;

__host__ __device__ __forceinline__ int lds_byte(int r, int c) { const int st = (r >> 4) * 2 + (c >> 5), rr = r & 15, cc = c & 31, ob = rr * 64 + cc * 2; return st * 1024 + (ob ^ (((ob >> 9) & 1) << 5)); }
__host__ __device__ __forceinline__ void stage_rc(int b, int& R, int& C) { const int st = b / 1024, sb = b % 1024, swz = sb ^ (((sb >> 9) & 1) << 5); R = (st >> 1) * 16 + swz / 64; C = (st & 1) * 32 + (swz % 64) / 2; }
__host__ __device__ __forceinline__ int perm32(int rho) { const int n = rho >> 4, i = rho & 15; return 8 * (i >> 2) + 4 * n + (i & 3); }

struct Unit { int pm, pn; };
struct Gemm { const bf16_t* A; const bf16_t* Bt; int M, N, K; };

struct StaticOrder {
    int nM, nN, nwg, G, c;
    __host__ __device__ void init(int M, int N, int G_, int c_) { nM = M / BM; nN = N / BM; nwg = nM * nN; G = G_; c = c_; }
    __host__ __device__ bool next(int i, Unit& u) const {
        const long L = (long)i * G + c; if (L >= nwg) return false;
        int wgid = (int)L; { const int q = nwg / NXCD, r = nwg % NXCD, xcd = wgid % NXCD, off = wgid / NXCD; wgid = (xcd < r ? xcd * (q + 1) : r * (q + 1) + (xcd - r) * q) + off; }
        const int nig = WGM * nN, gid = wgid / nig, fm = gid * WGM, gsz = (nM - fm) < WGM ? (nM - fm) : WGM;
        u.pm = fm + ((wgid % nig) % gsz); u.pn = (wgid % nig) / gsz; return true;
    }
    __device__ __forceinline__ void a_ready(const Unit&) const {}
    __device__ __forceinline__ void done(const Unit&) const {}
};

__device__ __forceinline__ unsigned cvt_pk_bf16(float lo, float hi) { unsigned r; asm volatile("v_cvt_pk_bf16_f32 %0, %1, %2" : "=v"(r) : "v"(lo), "v"(hi)); return r; }
typedef float f32x2 __attribute__((ext_vector_type(2)));
template <class Epi, class Sched, bool ALIGN_EPI = false, bool SP2 = false>
__device__ __forceinline__ void gemm_phase(PG8_LAS unsigned char* lds, const Gemm g, const Sched& S, const Epi& E, const int tid) {
    const int wid = __builtin_amdgcn_readfirstlane(tid >> 6), lane = tid & 63, wr = wid >> 2, wc = wid & 3, fr = lane & 15, fq = lane >> 4;
    const int K = g.K, nt = K / BK;
    unsigned voffA[2], voffB[2];
#pragma unroll
    for (int i = 0; i < 2; ++i) { int R, C; stage_rc(tid * 16 + i * 8192, R, C); const int Rb = Epi::PERM ? ((R & ~31) + perm32(R & 31)) : R;
        voffA[i] = (unsigned)(R * K + C) * 2u; voffB[i] = (unsigned)(Rb * K + C) * 2u; }
    const size_t kstep = (size_t)(BK * 2);
    const size_t hstep = (size_t)HALF * K * 2;
    const size_t tstep = 2 * hstep;
    const unsigned ldsw = (unsigned)wid * 1024u;
    const int aoff = lds_byte(wr * 64 + fr, fq * 8), boff = lds_byte(wc * 32 + fr, fq * 8);
#define PG8_SA(b, h) (((b) * 2 + (h)) * HTB)
#define PG8_SB(b, h) ((4 + (b) * 2 + (h)) * HTB)
#define PG8_STAGE(bufoff, gbase, voff) do { _Pragma("unroll") for (int _i = 0; _i < 2; ++_i) \
        __builtin_amdgcn_global_load_lds((const unsigned*)((const char*)(gbase) + (voff)[_i]), (PG8_LAS unsigned*)(lds + (bufoff) + ldsw + _i * 8192), 16, 0, 0); } while (0)
#define PG8_LDA(dst, b, h) do { _Pragma("unroll") for (int m = 0; m < 4; ++m) _Pragma("unroll") for (int k = 0; k < 2; ++k) dst[m][k] = *(const PG8_LAS bf16x8*)(lds + PG8_SA(b, h) + aoff + m * 2048 + k * 1024); } while (0)
#define PG8_LDB(dst, b, h) do { _Pragma("unroll") for (int n = 0; n < 2; ++n) _Pragma("unroll") for (int k = 0; k < 2; ++k) dst[n][k] = *(const PG8_LAS bf16x8*)(lds + PG8_SB(b, h) + boff + n * 2048 + k * 1024); } while (0)
#define PG8_MMA(ai, bj, At, Bt) do { __builtin_amdgcn_s_setprio(1); _Pragma("unroll") for (int m = 0; m < 4; ++m) _Pragma("unroll") for (int n = 0; n < 2; ++n) _Pragma("unroll") for (int k = 0; k < 2; ++k) \
        acc[ai][bj][m][n] = __builtin_amdgcn_mfma_f32_16x16x32_bf16(Bt[n][k], At[m][k], acc[ai][bj][m][n], 0, 0, 0); __builtin_amdgcn_s_setprio(0); } while (0)
#define PG8_WAIT_V(n) asm volatile("s_waitcnt vmcnt(" #n ")" ::: "memory")
#define PG8_WAIT_L(n) asm volatile("s_waitcnt lgkmcnt(" #n ")" ::: "memory")
#define PG8_BAR __builtin_amdgcn_s_barrier()
#define PG8_SCHED __builtin_amdgcn_sched_barrier(0)
    Unit cur, nxt; int ui = 0;
    if (!S.next(0, cur)) return;
    f32x4 acc[2][2][4][2];
#pragma unroll
    for (int a = 0; a < 2; ++a)
#pragma unroll
        for (int b = 0; b < 2; ++b)
#pragma unroll
            for (int m = 0; m < 4; ++m)
#pragma unroll
                for (int n = 0; n < 2; ++n) acc[a][b][m][n] = (f32x4){0.f, 0.f, 0.f, 0.f};
    bf16x8 At[4][2], B0[2][2], B1[2][2];
    const char* cA = (const char*)g.A + (size_t)cur.pm * tstep; const char* cB = (const char*)g.Bt + (size_t)cur.pn * tstep;
    S.a_ready(cur);
    if constexpr (SP2) {
        PG8_STAGE(PG8_SB(0, 0), cB, voffB); PG8_STAGE(PG8_SB(0, 1), cB + hstep, voffB); PG8_STAGE(PG8_SA(0, 0), cA, voffA); PG8_STAGE(PG8_SA(0, 1), cA + hstep, voffA);
        if (wr == 1) PG8_BAR;
        PG8_WAIT_V(2); PG8_BAR;
        PG8_STAGE(PG8_SB(1, 0), cB + kstep, voffB); PG8_STAGE(PG8_SA(1, 0), cA + kstep, voffA); PG8_STAGE(PG8_SB(1, 1), cB + hstep + kstep, voffB);
        PG8_WAIT_V(6); PG8_BAR;
    } else {
        PG8_STAGE(PG8_SB(0, 0), cB, voffB); PG8_STAGE(PG8_SA(0, 0), cA, voffA); PG8_STAGE(PG8_SB(0, 1), cB + hstep, voffB); PG8_STAGE(PG8_SA(0, 1), cA + hstep, voffA);
        if (wr == 1) PG8_BAR;
        PG8_WAIT_V(4); PG8_BAR;
        PG8_STAGE(PG8_SB(1, 0), cB + kstep, voffB); PG8_STAGE(PG8_SA(1, 0), cA + kstep, voffA); PG8_STAGE(PG8_SB(1, 1), cB + hstep + kstep, voffB);
        PG8_WAIT_V(6); PG8_BAR;
    }
    for (;;) {
        const bool has_next = S.next(ui + 1, nxt);
        const char* nA = has_next ? (const char*)g.A + (size_t)nxt.pm * tstep : cA; const char* nB = has_next ? (const char*)g.Bt + (size_t)nxt.pn * tstep : cB;
        for (int t = 0; t < nt; t += 2) {
            const bool last = (t == nt - 2);
            const char* a1 = cA + (size_t)(t + 1) * kstep;
            const char* a2 = last ? nA : cA + (size_t)(t + 2) * kstep; const char* b2 = last ? nB : cB + (size_t)(t + 2) * kstep;
            const char* a3 = a2 + kstep; const char* b3 = b2 + kstep;
            if (last && has_next) S.a_ready(nxt);
            if constexpr (SP2) {
            PG8_LDB(B0, 0, 0); PG8_LDB(B1, 0, 1); PG8_SCHED; PG8_LDA(At, 0, 0); PG8_STAGE(PG8_SA(1, 1), a1 + hstep, voffA);
            PG8_WAIT_V(8); PG8_WAIT_L(0); PG8_BAR; PG8_MMA(0, 0, At, B0); PG8_MMA(0, 1, At, B1); PG8_BAR; PG8_SCHED;
            PG8_LDA(At, 0, 1); PG8_STAGE(PG8_SB(0, 0), b2, voffB); PG8_STAGE(PG8_SB(0, 1), b2 + hstep, voffB); PG8_STAGE(PG8_SA(0, 0), a2, voffA);
            PG8_WAIT_V(8); PG8_WAIT_L(0); PG8_BAR; PG8_MMA(1, 0, At, B0); PG8_MMA(1, 1, At, B1); PG8_BAR; PG8_SCHED;
            PG8_LDB(B0, 1, 0); PG8_LDB(B1, 1, 1); PG8_SCHED; PG8_LDA(At, 1, 0); PG8_STAGE(PG8_SA(0, 1), a2 + hstep, voffA);
            PG8_WAIT_V(8); PG8_WAIT_L(0); PG8_BAR; PG8_MMA(0, 0, At, B0); PG8_MMA(0, 1, At, B1); PG8_BAR; PG8_SCHED;
            PG8_LDA(At, 1, 1); PG8_STAGE(PG8_SB(1, 0), b3, voffB); PG8_STAGE(PG8_SB(1, 1), b3 + hstep, voffB); PG8_STAGE(PG8_SA(1, 0), a3, voffA);
            PG8_WAIT_V(8); PG8_WAIT_L(0); PG8_BAR; PG8_MMA(1, 0, At, B0); PG8_MMA(1, 1, At, B1); PG8_BAR; PG8_SCHED;
            } else {
            PG8_LDB(B0, 0, 0); PG8_SCHED; PG8_LDA(At, 0, 0); PG8_STAGE(PG8_SA(1, 1), a1 + hstep, voffA);
            PG8_WAIT_L(8); PG8_BAR; PG8_WAIT_L(0); PG8_MMA(0, 0, At, B0); PG8_BAR; PG8_SCHED;
            PG8_LDB(B1, 0, 1); PG8_STAGE(PG8_SB(0, 0), b2, voffB);
            PG8_BAR; PG8_WAIT_L(0); PG8_MMA(0, 1, At, B1); PG8_BAR;
            PG8_LDA(At, 0, 1); PG8_STAGE(PG8_SA(0, 0), a2, voffA);
            PG8_BAR; PG8_WAIT_L(0); PG8_MMA(1, 0, At, B0); PG8_BAR; PG8_SCHED;
            PG8_STAGE(PG8_SB(0, 1), b2 + hstep, voffB);
            PG8_WAIT_V(6); PG8_BAR; PG8_MMA(1, 1, At, B1); PG8_BAR;
            PG8_LDB(B0, 1, 0); PG8_SCHED; PG8_LDA(At, 1, 0); PG8_STAGE(PG8_SA(0, 1), a2 + hstep, voffA);
            PG8_WAIT_L(8); PG8_BAR; PG8_WAIT_L(0); PG8_MMA(0, 0, At, B0); PG8_BAR; PG8_SCHED;
            PG8_LDB(B1, 1, 1); PG8_STAGE(PG8_SB(1, 0), b3, voffB);
            PG8_BAR; PG8_WAIT_L(0); PG8_MMA(0, 1, At, B1); PG8_BAR;
            PG8_LDA(At, 1, 1); PG8_STAGE(PG8_SA(1, 0), a3, voffA);
            PG8_BAR; PG8_WAIT_L(0); PG8_MMA(1, 0, At, B0); PG8_BAR; PG8_SCHED;
            PG8_STAGE(PG8_SB(1, 1), b3 + hstep, voffB);
            PG8_WAIT_V(6); PG8_BAR; PG8_MMA(1, 1, At, B1); PG8_BAR;
            }
        }
        if constexpr (ALIGN_EPI) { if (wr == 0) PG8_BAR; }
        if constexpr (!Epi::AFTER_DRAIN) { E(acc, cur, wr, wc, fr, fq); S.done(cur); }
        if (!has_next) break;
#pragma unroll
        for (int a = 0; a < 2; ++a)
#pragma unroll
            for (int b = 0; b < 2; ++b)
#pragma unroll
                for (int m = 0; m < 4; ++m)
#pragma unroll
                    for (int n = 0; n < 2; ++n) acc[a][b][m][n] = (f32x4){0.f, 0.f, 0.f, 0.f};
        cur = nxt; cA = nA; cB = nB; ++ui;
        if constexpr (ALIGN_EPI) { if (wr == 1) PG8_BAR; }
    }
    PG8_WAIT_V(0);
    if constexpr (!ALIGN_EPI) { if (wr == 0) PG8_BAR; }
    PG8_BAR;
    if constexpr (Epi::AFTER_DRAIN) { E.fused(acc, cur, wr, wc, fr, fq, lds, wid, lane); S.done(cur); }
#undef PG8_SA
#undef PG8_SB
#undef PG8_STAGE
#undef PG8_LDA
#undef PG8_LDB
#undef PG8_MMA
#undef PG8_WAIT_V
#undef PG8_WAIT_L
#undef PG8_BAR
#undef PG8_SCHED
}
}

#define DI __device__ __forceinline__
#define LAS __attribute__((address_space(3)))
typedef unsigned short bf16_t;
typedef short bf16x8 __attribute__((ext_vector_type(8)));
typedef short s16x4 __attribute__((ext_vector_type(4)));
typedef float f32x4 __attribute__((ext_vector_type(4)));
typedef float f32x16 __attribute__((ext_vector_type(16)));
typedef unsigned u32x4 __attribute__((ext_vector_type(4)));
typedef unsigned u32x2 __attribute__((ext_vector_type(2)));
typedef float f32x2_t __attribute__((ext_vector_type(2)));
typedef __bf16 bf16x2_t __attribute__((ext_vector_type(2)));
typedef short v4i16_t __attribute__((ext_vector_type(4)));

constexpr int SEQ = 8192, DM = 1024, MROWS = 16384;
constexpr int NWAVES = 8, NTHREADS = 512;
constexpr int LDS_BYTES = 155648;
constexpr float EPS = 1e-6f;
constexpr float LOG2E = 1.4426950408889634f, LN2 = 0.6931471805599453f;
constexpr float NEGB = -1e30f;

constexpr size_t MiB = 1u << 20;
constexpr size_t WS_WA_IN = 0, WS_WB_IN = 40 * MiB, WS_WA_OUT = 56 * MiB, WS_WB_OUT = 60 * MiB;
constexpr size_t WS_XG = 64 * MiB, WS_Z = 96 * MiB, WS_QKV = 128 * MiB;
constexpr size_t WS_SSQ = 272 * MiB, WS_LSE = 273 * MiB, WS_ROPE = 274 * MiB, WS_END = 276 * MiB;

struct Params {
    const float* x; const float* a_norm; const float* a_w_in; const float* a_w_out;
    const float* b_norm; const float* b_w_in; const float* b_lambda; const float* b_subln; const float* b_w_out; const float* final_norm;
    float* out; unsigned char* ws; int ph_lo, ph_hi;
};

DI unsigned cvtpk(float lo, float hi) { f32x2_t v = {lo, hi}; bf16x2_t b = __builtin_convertvector(v, bf16x2_t); return __builtin_bit_cast(unsigned, b); }
DI float bf2f(unsigned short b) { return __uint_as_float(((unsigned)b) << 16); }
DI int crow(int r, int hi) { return (r & 3) + 8 * (r >> 2) + 4 * hi; }
DI s16x4 vtr(const LAS char* p) { return __builtin_bit_cast(s16x4, __builtin_amdgcn_ds_read_tr16_b64_v4i16((LAS v4i16_t*)p)); }
DI float fexp2(float x) { return __builtin_amdgcn_exp2f(x); }
DI float silu(float z) { return z / (1.f + __expf(-z)); }
DI float wave_sum(float v) {
#pragma unroll
    for (int o = 1; o < 64; o <<= 1) v += __shfl_xor(v, o);
    return v;
}
#define MFMA32(a, b, c) __builtin_amdgcn_mfma_f32_32x32x16_bf16((a), (b), (c), 0, 0, 0)

using pg8::Unit;
struct EpiInA {
    static constexpr bool PERM = true, AFTER_DRAIN = false;
    bf16_t* qkv; bf16_t* z; const float* ssq; const float* cs; const float* sn; float qscale;
    DI void operator()(const f32x4 (&acc)[2][2][4][2], const Unit& u, int wr, int wc, int fr, int fq) const {
        const int ct = u.pn; bf16_t* base; int kind;
        if (ct < 36) { const int g = ct / 12, t = (ct % 12) >> 2; kind = t; base = qkv + (size_t)(g * 3 + t) * ((size_t)SEQ * DM) + (ct & 3) * 256; }
        else { kind = 3; base = z + (ct - 36) * 256; }
        const bool rot = (kind < 2) && (wc == 0);
        const float osc = (kind == 0) ? qscale : 1.f;
#pragma unroll
        for (int ai = 0; ai < 2; ++ai)
#pragma unroll
            for (int m = 0; m < 4; ++m) {
                const int row = u.pm * 256 + ai * 128 + wr * 64 + m * 16 + fr;
                const f32x4* sp = (const f32x4*)(ssq + (size_t)row * 16);
                const f32x4 pa = sp[0], pb = sp[1], pc = sp[2], pd = sp[3];
                const float ss = (((pa.x + pa.y) + (pa.z + pa.w)) + ((pb.x + pb.y) + (pb.z + pb.w))) + (((pc.x + pc.y) + (pc.z + pc.w)) + ((pd.x + pd.y) + (pd.z + pd.w)));
                const float rs = 1.0f / sqrtf(ss * (1.0f / DM) + EPS);
                f32x4 c0 = {1.f, 1.f, 1.f, 1.f}, c1 = c0, s0 = {0.f, 0.f, 0.f, 0.f}, s1 = s0;
                if (rot) { const int ib = row * 16 + 8 * (fq & 1); c0 = *(const f32x4*)(cs + ib); c1 = *(const f32x4*)(cs + ib + 4); s0 = *(const f32x4*)(sn + ib); s1 = *(const f32x4*)(sn + ib + 4);
                           if (fq < 2) { s0 = -s0; s1 = -s1; } }
#pragma unroll
                for (int bj = 0; bj < 2; ++bj) {
                    f32x4 v0 = acc[ai][bj][m][0] * rs, v1 = acc[ai][bj][m][1] * rs;
                    if (rot) {
                        f32x4 p0, p1;
#pragma unroll
                        for (int j = 0; j < 4; ++j) { p0[j] = __shfl_xor(v0[j], 32); p1[j] = __shfl_xor(v1[j], 32); }
                        v0 = v0 * c0 + p0 * s0; v1 = v1 * c1 + p1 * s1;
                    }
                    v0 = v0 * osc; v1 = v1 * osc;
                    u32x4 w; w.x = cvtpk(v0[0], v0[1]); w.y = cvtpk(v0[2], v0[3]); w.z = cvtpk(v1[0], v1[1]); w.w = cvtpk(v1[2], v1[3]);
                    *(u32x4*)(base + (size_t)row * DM + bj * 128 + wc * 32 + 8 * fq) = w;
                }
            }
    }
};
struct EpiInB {
    static constexpr bool PERM = true, AFTER_DRAIN = false;
    bf16_t* qkv; bf16_t* z; const float* ssq; const float* cs; const float* sn; float qscale;
    DI void operator()(const f32x4 (&acc)[2][2][4][2], const Unit& u, int wr, int wc, int fr, int fq) const {
        const int ct = u.pn; const int kind = ct >> 2;
        bf16_t* base = (kind < 3 ? qkv + (size_t)kind * ((size_t)MROWS * DM) : z) + (ct & 3) * 256;
        const bool rot = (kind < 2) && ((wc & 1) == 0);
        const float osc = (kind == 0) ? qscale : 1.f;
#pragma unroll
        for (int ai = 0; ai < 2; ++ai)
#pragma unroll
            for (int m = 0; m < 4; ++m) {
                const int row = u.pm * 256 + ai * 128 + wr * 64 + m * 16 + fr;
                const f32x4* sp = (const f32x4*)(ssq + (size_t)row * 16);
                const f32x4 pa = sp[0], pb = sp[1], pc = sp[2], pd = sp[3];
                const float ss = (((pa.x + pa.y) + (pa.z + pa.w)) + ((pb.x + pb.y) + (pb.z + pb.w))) + (((pc.x + pc.y) + (pc.z + pc.w)) + ((pd.x + pd.y) + (pd.z + pd.w)));
                const float rs = 1.0f / sqrtf(ss * (1.0f / DM) + EPS);
                f32x4 c0 = {1.f, 1.f, 1.f, 1.f}, c1 = c0, s0 = {0.f, 0.f, 0.f, 0.f}, s1 = s0;
                if (rot && fq < 2) { const int ib = (row & (SEQ - 1)) * 8; c0 = *(const f32x4*)(cs + ib); c1 = *(const f32x4*)(cs + ib + 4); s0 = *(const f32x4*)(sn + ib); s1 = *(const f32x4*)(sn + ib + 4);
                                     if (fq == 0) { s0 = -s0; s1 = -s1; } }
#pragma unroll
                for (int bj = 0; bj < 2; ++bj) {
                    f32x4 v0 = acc[ai][bj][m][0] * rs, v1 = acc[ai][bj][m][1] * rs;
                    if (rot) {
                        f32x4 p0, p1;
#pragma unroll
                        for (int j = 0; j < 4; ++j) { p0[j] = __shfl_xor(v0[j], 16); p1[j] = __shfl_xor(v1[j], 16); }
                        v0 = v0 * c0 + p0 * s0; v1 = v1 * c1 + p1 * s1;
                    }
                    v0 = v0 * osc; v1 = v1 * osc;
                    u32x4 w; w.x = cvtpk(v0[0], v0[1]); w.y = cvtpk(v0[2], v0[3]); w.z = cvtpk(v1[0], v1[1]); w.w = cvtpk(v1[2], v1[3]);
                    *(u32x4*)(base + (size_t)row * DM + bj * 128 + wc * 32 + 8 * fq) = w;
                }
            }
    }
};
struct EpiOut {
    static constexpr bool PERM = false, AFTER_DRAIN = false;
    const float* xin; float* xout; bf16_t* xg; const float* gnext; float* ssq;
    DI void operator()(const f32x4 (&acc)[2][2][4][2], const Unit& u, int wr, int wc, int fr, int fq) const {
#pragma unroll
        for (int ai = 0; ai < 2; ++ai)
#pragma unroll
            for (int m = 0; m < 4; ++m) {
                const int row = u.pm * 256 + ai * 128 + wr * 64 + m * 16 + fr;
                float ss = 0.f;
#pragma unroll
                for (int bj = 0; bj < 2; ++bj)
#pragma unroll
                    for (int n = 0; n < 2; ++n) {
                        const int col = u.pn * 256 + bj * 128 + wc * 32 + n * 16 + 4 * fq;
                        const size_t off = (size_t)row * DM + col;
                        const f32x4 v = *(const f32x4*)(xin + off) + acc[ai][bj][m][n];
                        *(f32x4*)(xout + off) = v;
                        ss += (v.x * v.x + v.y * v.y) + (v.z * v.z + v.w * v.w);
                        if (gnext) { const f32x4 g4 = *(const f32x4*)(gnext + col); u32x2 w; w.x = cvtpk(v.x * g4.x, v.y * g4.y); w.y = cvtpk(v.z * g4.z, v.w * g4.w); *(u32x2*)(xg + off) = w; }
                    }
                ss += __shfl_xor(ss, 16); ss += __shfl_xor(ss, 32);
                if (fq == 0) ssq[(size_t)row * 16 + u.pn * 4 + wc] = ss;
            }
    }
};

DI unsigned f2bf(float f) { unsigned u = __builtin_bit_cast(unsigned, f); return (u + 0x7fffu + ((u >> 16) & 1u)) >> 16; }
DI unsigned pk2(float lo, float hi) { return f2bf(lo) | (f2bf(hi) << 16); }
DI void transpose_item(const float* W, int K, int N, bf16_t* WT, LAS float* scr, int item, int lane) {
    const int nblk = N / 32, kb = item / nblk, nb = item % nblk, k0 = 64 * kb, n0 = 32 * nb;
#pragma unroll 8
    for (int i = 0; i < 32; ++i) { const int kk = 2 * i + (lane >> 5); scr[kk * 33 + (lane & 31)] = W[(size_t)(k0 + kk) * N + n0 + (lane & 31)]; }
    asm volatile("s_waitcnt lgkmcnt(0)" ::: "memory");
    const int c = lane & 7;
#pragma unroll
    for (int j = 0; j < 4; ++j) { const int n = (lane >> 3) + 8 * j; const LAS float* s = scr + (8 * c) * 33 + n;
        u32x4 o; o.x = pk2(s[0 * 33], s[1 * 33]); o.y = pk2(s[2 * 33], s[3 * 33]); o.z = pk2(s[4 * 33], s[5 * 33]); o.w = pk2(s[6 * 33], s[7 * 33]);
        *(u32x4*)(WT + (size_t)(n0 + n) * K + k0 + 8 * c) = o; }
    asm volatile("s_waitcnt lgkmcnt(0)" ::: "memory");
}

__constant__ float ROPE_INV[16] = {1.0f, 0.44036662578582764f, 0.193922758102417f, 0.08539710193872452f, 0.03760603070259094f, 0.016560440883040428f, 0.00729266507551074f, 0.0032114461064338684f,
                                   0.001414213445968926f, 0.0006227724370546639f, 0.00027424818836152554f, 0.00012076974235242233f, 5.318296462064609e-05f, 2.3419997887685895e-05f, 1.0313385246263351e-05f, 4.541670477919979e-06f};
DI void phase_prologue(const Params& p, LAS unsigned char* lds, int tid, int wid, int lane) {
    unsigned char* ws = p.ws;
    LAS float* scr = (LAS float*)(lds + wid * 16384);
    const int gw = blockIdx.x * NWAVES + wid, NGW = gridDim.x * NWAVES;
    constexpr int I_AIN = 16 * 320, I_OUT = 16 * 32, I_BIN = 16 * 128, PER_J = I_AIN + 2 * I_OUT + I_BIN;
    for (int it = gw; it < 2 * PER_J; it += NGW) {
        const int j = it / PER_J; int r = it % PER_J;
        if (r < I_AIN) { transpose_item(p.a_w_in + (size_t)j * 1024 * 10240, 1024, 10240, (bf16_t*)(ws + WS_WA_IN) + (size_t)j * 10240 * 1024, scr, r, lane); continue; } r -= I_AIN;
        if (r < I_OUT) { transpose_item(p.a_w_out + (size_t)j * 1024 * 1024, 1024, 1024, (bf16_t*)(ws + WS_WA_OUT) + (size_t)j * 1024 * 1024, scr, r, lane); continue; } r -= I_OUT;
        if (r < I_BIN) { transpose_item(p.b_w_in + (size_t)j * 1024 * 4096, 1024, 4096, (bf16_t*)(ws + WS_WB_IN) + (size_t)j * 4096 * 1024, scr, r, lane); continue; } r -= I_BIN;
        transpose_item(p.b_w_out + (size_t)j * 1024 * 1024, 1024, 1024, (bf16_t*)(ws + WS_WB_OUT) + (size_t)j * 1024 * 1024, scr, r, lane);
    }
    bf16_t* xg = (bf16_t*)(ws + WS_XG); float* ssq = (float*)(ws + WS_SSQ);
    for (int m = gw; m < MROWS; m += NGW) {
        const f32x4* xr = (const f32x4*)(p.x + (size_t)m * DM) + lane; const f32x4* gr = (const f32x4*)p.a_norm + lane;
        float s = 0.f;
#pragma unroll
        for (int j = 0; j < 4; ++j) { const f32x4 v = xr[64 * j], g = gr[64 * j]; s += (v.x * v.x + v.y * v.y) + (v.z * v.z + v.w * v.w);
            u32x2 w; w.x = cvtpk(v.x * g.x, v.y * g.y); w.y = cvtpk(v.z * g.z, v.w * g.w); *((u32x2*)(xg + (size_t)m * DM) + lane + 64 * j) = w; }
        s = wave_sum(s);
        if (lane < 16) ssq[(size_t)m * 16 + lane] = (lane == 0) ? s : 0.f;
    }
    float* cosA = (float*)(ws + WS_ROPE); float* sinA = cosA + SEQ * 16; float* cosB = sinA + SEQ * 16; float* sinB = cosB + SEQ * 8;
    for (int idx = blockIdx.x * NTHREADS + tid; idx < SEQ * 24; idx += gridDim.x * NTHREADS) {
        int pos, i, rotd; float* cd; float* sd;
        if (idx < SEQ * 16) { pos = idx >> 4; i = idx & 15; rotd = 32; cd = cosA + idx; sd = sinA + idx; }
        else { const int k = idx - SEQ * 16; pos = k >> 3; i = k & 7; rotd = 16; cd = cosB + k; sd = sinB + k; }
        const float inv = ROPE_INV[(rotd == 32) ? i : 2 * i];
        const float ang = (float)pos * inv;
        const double rev = (double)ang * 0.15915494309189535;
        const double fr = rev - rint(rev);
        *cd = __builtin_amdgcn_cosf((float)fr); *sd = __builtin_amdgcn_sinf((float)fr);
    }
}

constexpr int AW_K = 0, AW_V = 8704, AW_BYTES = 18944;
DI void attnA_item(LAS char* wl, bf16_t* Qb, const bf16_t* Kb, const bf16_t* Vb, float* lse, int r, int rho, int c, int h, int lane) {
    const int q = lane & 31, hh = lane >> 5, lr = lane >> 4, lc = lane & 15;
    const int tq = rho + r * (32 * c + q);
    bf16_t* Qrow = Qb + (size_t)tq * DM + h * 128;
    bf16x8 qf[8];
#pragma unroll
    for (int st = 0; st < 8; ++st) qf[st] = *(const bf16x8*)(Qrow + 16 * st + 8 * hh);
    f32x16 o[4];
#pragma unroll
    for (int db = 0; db < 4; ++db)
#pragma unroll
        for (int i = 0; i < 16; ++i) o[db][i] = 0.f;
    float m_run = NEGB, l_run = 0.f;
    const int t_lo = (c - 4 > 0) ? c - 4 : 0;
    u32x4 kreg[8], vreg[8];
    {
        const size_t tok0 = (size_t)(rho + r * (32 * t_lo + lr));
#pragma unroll
        for (int it = 0; it < 8; ++it) { const size_t off = (tok0 + (size_t)r * 4 * it) * DM + h * 128 + lc * 8; kreg[it] = *(const u32x4*)(Kb + off); vreg[it] = *(const u32x4*)(Vb + off); }
    }
    const LAS char* vb = wl + AW_V + (4 * hh + (lc >> 2)) * 320 + (lr & 1) * 32 + (lane & 3) * 8;
    for (int t = t_lo; t <= c; ++t) {
#pragma unroll
        for (int it = 0; it < 8; ++it) { *(LAS u32x4*)(wl + AW_K + (4 * it + lr) * 272 + lc * 16) = kreg[it]; *(LAS u32x4*)(wl + AW_V + (4 * it + lr) * 320 + lc * 16) = vreg[it]; }
        if (t < c) {
            const size_t tok0 = (size_t)(rho + r * (32 * (t + 1) + lr));
#pragma unroll
            for (int it = 0; it < 8; ++it) { const size_t off = (tok0 + (size_t)r * 4 * it) * DM + h * 128 + lc * 8; kreg[it] = *(const u32x4*)(Kb + off); vreg[it] = *(const u32x4*)(Vb + off); }
        }
        f32x16 s;
#pragma unroll
        for (int i = 0; i < 16; ++i) s[i] = 0.f;
#pragma unroll
        for (int st = 0; st < 8; ++st) { const bf16x8 a = *(const LAS bf16x8*)(wl + AW_K + q * 272 + st * 32 + hh * 16); s = MFMA32(a, qf[st], s); }
        if (t == c) {
#pragma unroll
            for (int i = 0; i < 16; ++i) if (crow(i, hh) > q) s[i] = NEGB;
        }
        if (t == c - 4) {
#pragma unroll
            for (int i = 0; i < 16; ++i) if (crow(i, hh) < q) s[i] = NEGB;
        }
        float mx = s[0];
#pragma unroll
        for (int i = 1; i < 16; ++i) mx = fmaxf(mx, s[i]);
        mx = fmaxf(mx, __shfl_xor(mx, 32));
        const float m_new = fmaxf(m_run, mx);
        const float alpha = fexp2(m_run - m_new);
        m_run = m_new;
        float ps = 0.f;
#pragma unroll
        for (int i = 0; i < 16; ++i) { s[i] = fexp2(s[i] - m_new); ps += s[i]; }
        l_run = l_run * alpha + ps;
#pragma unroll
        for (int db = 0; db < 4; ++db)
#pragma unroll
            for (int i = 0; i < 16; ++i) o[db][i] *= alpha;
        bf16x8 pf[2];
#pragma unroll
        for (int s2 = 0; s2 < 2; ++s2) { u32x4 w; w.x = cvtpk(s[8 * s2], s[8 * s2 + 1]); w.y = cvtpk(s[8 * s2 + 2], s[8 * s2 + 3]); w.z = cvtpk(s[8 * s2 + 4], s[8 * s2 + 5]); w.w = cvtpk(s[8 * s2 + 6], s[8 * s2 + 7]); pf[s2] = __builtin_bit_cast(bf16x8, w); }
#pragma unroll
        for (int db = 0; db < 4; ++db)
#pragma unroll
            for (int s2 = 0; s2 < 2; ++s2) {
                const s16x4 lo = vtr(vb + (16 * s2) * 320 + db * 64), hi = vtr(vb + (16 * s2 + 8) * 320 + db * 64);
                const bf16x8 a = (bf16x8){lo[0], lo[1], lo[2], lo[3], hi[0], hi[1], hi[2], hi[3]};
                o[db] = MFMA32(a, pf[s2], o[db]);
            }
    }
    const float l_tot = l_run + __shfl_xor(l_run, 32);
    const float inv = 1.0f / l_tot;
#pragma unroll
    for (int db = 0; db < 4; ++db)
#pragma unroll
        for (int i4 = 0; i4 < 4; ++i4) {
            u32x2 w; w.x = cvtpk(o[db][4 * i4] * inv, o[db][4 * i4 + 1] * inv); w.y = cvtpk(o[db][4 * i4 + 2] * inv, o[db][4 * i4 + 3] * inv);
            *(u32x2*)(Qrow + 32 * db + 8 * i4 + 4 * hh) = w;
        }
    if (hh == 0) lse[(size_t)tq * 8 + h] = (m_run + __log2f(l_tot)) * LN2;
}

DI void phase_attnA(const Params& p, LAS unsigned char* lds, int wid, int lane) {
    bf16_t* qkv = (bf16_t*)(p.ws + WS_QKV); float* lse = (float*)(p.ws + WS_LSE);
    LAS char* wl = (LAS char*)lds + wid * AW_BYTES;
    const int gw = blockIdx.x * NWAVES + wid, NGW = gridDim.x * NWAVES;
    for (int id = gw; id < 3 * 2048; id += NGW) {
        const int g = id >> 11, rem = id & 2047, h = rem >> 8, cc = rem & 255;
        const int r = (g == 0) ? 1 : (g == 1) ? 4 : 16;
        const int cpr = 256 / r;
        const int rho = cc / cpr, c = cc % cpr;
        bf16_t* Qb = qkv + (size_t)(g * 3 + 0) * ((size_t)SEQ * DM);
        const bf16_t* Kb = qkv + (size_t)(g * 3 + 1) * ((size_t)SEQ * DM);
        const bf16_t* Vb = qkv + (size_t)(g * 3 + 2) * ((size_t)SEQ * DM);
        attnA_item(wl, Qb, Kb, Vb, lse + (size_t)g * SEQ * 8, r, rho, c, h, lane);
    }
}

DI void phase_combineA(const Params& p, int bidx, int tid) {
    const bf16_t* qkv = (const bf16_t*)(p.ws + WS_QKV); const float* lse = (const float*)(p.ws + WS_LSE);
    bf16_t* zb = (bf16_t*)(p.ws + WS_Z) + (size_t)bidx * SEQ * DM;
    for (int idx = blockIdx.x * NTHREADS + tid; idx < SEQ * 128; idx += gridDim.x * NTHREADS) {
        const int row = idx >> 7, ch = idx & 127, head = ch >> 4;
        const float l0 = lse[(size_t)row * 8 + head], l1 = lse[(size_t)(SEQ + row) * 8 + head], l2 = lse[(size_t)(2 * SEQ + row) * 8 + head];
        const float mx = fmaxf(l0, fmaxf(l1, l2));
        float e0 = __expf(l0 - mx), e1 = __expf(l1 - mx), e2 = __expf(l2 - mx);
        const float inv = 1.0f / (e0 + e1 + e2); e0 *= inv; e1 *= inv; e2 *= inv;
        const size_t off = (size_t)row * DM + ch * 8;
        const u32x4 a0 = *(const u32x4*)(qkv + off), a1 = *(const u32x4*)(qkv + (size_t)3 * SEQ * DM + off), a2 = *(const u32x4*)(qkv + (size_t)6 * SEQ * DM + off);
        const u32x4 zz = *(const u32x4*)(zb + off);
        u32x4 w;
#pragma unroll
        for (int k = 0; k < 4; ++k) {
            const float o_lo = e0 * __uint_as_float(a0[k] << 16) + e1 * __uint_as_float(a1[k] << 16) + e2 * __uint_as_float(a2[k] << 16);
            const float o_hi = e0 * __uint_as_float(a0[k] & 0xffff0000u) + e1 * __uint_as_float(a1[k] & 0xffff0000u) + e2 * __uint_as_float(a2[k] & 0xffff0000u);
            const float z_lo = __uint_as_float(zz[k] << 16), z_hi = __uint_as_float(zz[k] & 0xffff0000u);
            w[k] = cvtpk(o_lo * silu(z_lo), o_hi * silu(z_hi));
        }
        *(u32x4*)(zb + off) = w;
    }
}

constexpr int BB_BUF = 37888, BB_V = 17408, BB_EX = 75776;
DI void attnB_unit(LAS char* lds, const bf16_t* Q, const bf16_t* K, const bf16_t* V, bf16_t* Z, const float* subln, int b, int h, int qb, float lam, float oscale, int tid, int wid, int lane) {
    const int strm = wid >> 2, wq = wid & 3, q = lane & 31, hh = lane >> 5;
    const int q0 = qb * 128 + wq * 32;
    const size_t rowbase = (size_t)b * SEQ;
    const bf16_t* Qrow = Q + (rowbase + q0 + q) * DM + h * 128 + strm * 64;
    bf16x8 qf[4];
#pragma unroll
    for (int st = 0; st < 4; ++st) qf[st] = *(const bf16x8*)(Qrow + 16 * st + 8 * hh);
    f32x16 o[4];
#pragma unroll
    for (int db = 0; db < 4; ++db)
#pragma unroll
        for (int i = 0; i < 16; ++i) o[db][i] = 0.f;
    float m_run = NEGB, l_run = 0.f;
    const int NT = 2 * qb + 2;
    const bf16_t* Kg = K + rowbase * DM + h * 128; const bf16_t* Vg = V + rowbase * DM + h * 128;
    const int lrow = tid >> 4, lcc = tid & 15;
    u32x4 kr[2], vr[2];
#define BB_GLOAD(t) do { _Pragma("unroll") for (int i_ = 0; i_ < 2; ++i_) { const size_t off_ = (size_t)(64 * (t) + lrow + 32 * i_) * DM + lcc * 8; kr[i_] = *(const u32x4*)(Kg + off_); vr[i_] = *(const u32x4*)(Vg + off_); } } while (0)
#define BB_LSTORE(buf) do { _Pragma("unroll") for (int i_ = 0; i_ < 2; ++i_) { *(LAS u32x4*)(lds + (buf) * BB_BUF + (lrow + 32 * i_) * 272 + lcc * 16) = kr[i_]; *(LAS u32x4*)(lds + (buf) * BB_BUF + BB_V + (lrow + 32 * i_) * 320 + lcc * 16) = vr[i_]; } } while (0)
    BB_GLOAD(0); BB_LSTORE(0);
    __syncthreads();
    for (int t = 0; t < NT; ++t) {
        const int buf = t & 1;
        if (t + 1 < NT) BB_GLOAD(t + 1);
        if (64 * t <= q0 + 31) {
            const LAS char* kb = lds + buf * BB_BUF;
            const LAS char* vb = kb + BB_V + (4 * hh + ((lane & 15) >> 2)) * 320 + ((lane >> 4) & 1) * 32 + (lane & 3) * 8;
            f32x16 p0, p1;
#pragma unroll
            for (int i = 0; i < 16; ++i) { p0[i] = 0.f; p1[i] = 0.f; }
#pragma unroll
            for (int st = 0; st < 4; ++st) {
                const bf16x8 a0 = *(const LAS bf16x8*)(kb + q * 272 + strm * 128 + st * 32 + hh * 16);
                const bf16x8 a1 = *(const LAS bf16x8*)(kb + (q + 32) * 272 + strm * 128 + st * 32 + hh * 16);
                p0 = MFMA32(a0, qf[st], p0); p1 = MFMA32(a1, qf[st], p1);
            }
            if (64 * t + 63 > q0) {
                const int qrel = q0 + q - 64 * t;
#pragma unroll
                for (int i = 0; i < 16; ++i) { const int kv = crow(i, hh); if (kv > qrel) p0[i] = NEGB; if (kv + 32 > qrel) p1[i] = NEGB; }
            }
            float mx = fmaxf(p0[0], p1[0]);
#pragma unroll
            for (int i = 1; i < 16; ++i) mx = fmaxf(mx, fmaxf(p0[i], p1[i]));
            mx = fmaxf(mx, __shfl_xor(mx, 32));
            const float m_new = fmaxf(m_run, mx);
            const float alpha = fexp2(m_run - m_new);
            m_run = m_new;
            float ps = 0.f;
#pragma unroll
            for (int i = 0; i < 16; ++i) { p0[i] = fexp2(p0[i] - m_new); p1[i] = fexp2(p1[i] - m_new); ps += p0[i] + p1[i]; }
            l_run = l_run * alpha + ps;
#pragma unroll
            for (int db = 0; db < 4; ++db)
#pragma unroll
                for (int i = 0; i < 16; ++i) o[db][i] *= alpha;
            bf16x8 pf[4];
#pragma unroll
            for (int s2 = 0; s2 < 2; ++s2) {
                u32x4 w; w.x = cvtpk(p0[8 * s2], p0[8 * s2 + 1]); w.y = cvtpk(p0[8 * s2 + 2], p0[8 * s2 + 3]); w.z = cvtpk(p0[8 * s2 + 4], p0[8 * s2 + 5]); w.w = cvtpk(p0[8 * s2 + 6], p0[8 * s2 + 7]); pf[s2] = __builtin_bit_cast(bf16x8, w);
                u32x4 x; x.x = cvtpk(p1[8 * s2], p1[8 * s2 + 1]); x.y = cvtpk(p1[8 * s2 + 2], p1[8 * s2 + 3]); x.z = cvtpk(p1[8 * s2 + 4], p1[8 * s2 + 5]); x.w = cvtpk(p1[8 * s2 + 6], p1[8 * s2 + 7]); pf[2 + s2] = __builtin_bit_cast(bf16x8, x);
            }
#pragma unroll
            for (int db = 0; db < 4; ++db)
#pragma unroll
                for (int s2 = 0; s2 < 4; ++s2) {
                    const s16x4 lo = vtr(vb + (16 * s2) * 320 + db * 64), hi = vtr(vb + (16 * s2 + 8) * 320 + db * 64);
                    const bf16x8 a = (bf16x8){lo[0], lo[1], lo[2], lo[3], hi[0], hi[1], hi[2], hi[3]};
                    o[db] = MFMA32(a, pf[s2], o[db]);
                    if (s2 == 3) __builtin_amdgcn_sched_barrier(0);
                }
        }
        if (t + 1 < NT) BB_LSTORE(buf ^ 1);
        __syncthreads();
    }
#undef BB_GLOAD
#undef BB_LSTORE
    const float l_tot = l_run + __shfl_xor(l_run, 32);
    const float inv = 1.0f / l_tot;
    LAS float* ex = (LAS float*)(lds + BB_EX) + wq * 4096;
    if (strm == 1) {
#pragma unroll
        for (int db = 0; db < 4; ++db)
#pragma unroll
            for (int i = 0; i < 16; ++i) ex[(db * 16 + i) * 64 + lane] = o[db][i] * inv;
    }
    __syncthreads();
    if (strm == 0) {
        float ss = 0.f;
#pragma unroll
        for (int db = 0; db < 4; ++db) {
#pragma unroll
            for (int i = 0; i < 16; ++i) { const float d = o[db][i] * inv - lam * ex[(db * 16 + i) * 64 + lane]; o[db][i] = d; ss += d * d; }
            __builtin_amdgcn_sched_barrier(0); }
        ss += __shfl_xor(ss, 32);
        const float rn = (1.0f / sqrtf(ss * (1.0f / 128.0f) + EPS)) * oscale;
        bf16_t* Zrow = Z + (rowbase + q0 + q) * DM + h * 128;
#pragma unroll
        for (int db = 0; db < 4; ++db)
#pragma unroll
            for (int i4 = 0; i4 < 4; ++i4) {
                const int d0 = 32 * db + 8 * i4 + 4 * hh;
                const u32x2 zz = *(const u32x2*)(Zrow + d0);
                const f32x4 sl = *(const f32x4*)(subln + d0);
                const float z0 = __uint_as_float(zz.x << 16), z1 = __uint_as_float(zz.x & 0xffff0000u), z2 = __uint_as_float(zz.y << 16), z3 = __uint_as_float(zz.y & 0xffff0000u);
                u32x2 w; w.x = cvtpk(o[db][4 * i4] * rn * sl.x * silu(z0), o[db][4 * i4 + 1] * rn * sl.y * silu(z1));
                w.y = cvtpk(o[db][4 * i4 + 2] * rn * sl.z * silu(z2), o[db][4 * i4 + 3] * rn * sl.w * silu(z3));
                *(u32x2*)(Zrow + d0) = w;
                __builtin_amdgcn_sched_barrier(0);
            }
    }
}

DI void phase_attnB(const Params& p, LAS unsigned char* lds, int j, int layer, int tid, int wid, int lane) {
    const bf16_t* Q = (const bf16_t*)(p.ws + WS_QKV); const bf16_t* K = Q + (size_t)MROWS * DM; const bf16_t* V = K + (size_t)MROWS * DM;
    bf16_t* Z = (bf16_t*)(p.ws + WS_Z);
    const float* lp = p.b_lambda + j * 256;
    const float d1 = wave_sum(lp[lane] * lp[64 + lane]), d2 = wave_sum(lp[128 + lane] * lp[192 + lane]);
    const float lam_init = 0.8f - 0.6f * expf(-0.3f * (float)layer);
    const float lam = expf(d1) - expf(d2) + lam_init;
    const float oscale = 1.0f - lam_init;
    const float* subln = p.b_subln + j * 128;
    for (int v = blockIdx.x; v < 256; v += gridDim.x) {
        const int bh = v >> 4, s = v & 15;
#pragma unroll 1
        for (int k = 0; k < 4; ++k) {
            const int qb = (k == 0) ? 63 - s : (k == 1) ? 32 + s : (k == 2) ? 31 - s : s;
            attnB_unit((LAS char*)lds, Q, K, V, Z, subln, bh >> 3, bh & 7, qb, lam, oscale, tid, wid, lane);
        }
    }
}

DI void phase_final(const Params& p, int wid, int lane) {
    const int gw = blockIdx.x * NWAVES + wid, NGW = gridDim.x * NWAVES;
    for (int m = gw; m < MROWS; m += NGW) {
        f32x4* xr = (f32x4*)(p.out + (size_t)m * DM) + lane; const f32x4* gr = (const f32x4*)p.final_norm + lane;
        f32x4 v[4]; float s = 0.f;
#pragma unroll
        for (int j = 0; j < 4; ++j) { v[j] = xr[64 * j]; s += (v[j].x * v[j].x + v[j].y * v[j].y) + (v[j].z * v[j].z + v[j].w * v[j].w); }
        const float rs = 1.0f / sqrtf(wave_sum(s) * (1.0f / DM) + EPS);
#pragma unroll
        for (int j = 0; j < 4; ++j) xr[64 * j] = v[j] * rs * gr[64 * j];
    }
}

__global__ void __launch_bounds__(NTHREADS, 2) fwd_megakernel(Params p_arg) {
    extern __shared__ __attribute__((aligned(16))) unsigned char lds_raw[];
    LAS unsigned char* lds = (LAS unsigned char*)lds_raw;
    cg::grid_group grid = cg::this_grid();
    const int lo = p_arg.ph_lo, hi = p_arg.ph_hi;
#pragma unroll 1
    for (int ph = lo; ph < hi; ++ph) {
        int tid = threadIdx.x; asm volatile("" : "+v"(tid));
#if defined(__HIP_DEVICE_COMPILE__)
        const __attribute__((address_space(4))) Params* pp = (const __attribute__((address_space(4))) Params*)__builtin_amdgcn_kernarg_segment_ptr();
        asm volatile("" : "+s"(pp));
        const Params p = *pp;
#else
        const Params p = p_arg;
#endif
        const int lane = tid & 63, wid = __builtin_amdgcn_readfirstlane(tid >> 6);
        unsigned char* ws = p.ws;
        bf16_t* XG = (bf16_t*)(ws + WS_XG); bf16_t* Zb = (bf16_t*)(ws + WS_Z); bf16_t* QKV = (bf16_t*)(ws + WS_QKV);
        float* SSQ = (float*)(ws + WS_SSQ);
        const float* cosA = (const float*)(ws + WS_ROPE); const float* sinA = cosA + SEQ * 16; const float* cosB = sinA + SEQ * 16; const float* sinB = cosB + SEQ * 8;
        if (ph == 0) phase_prologue(p, lds, tid, wid, lane);
        else if (ph == 21) phase_final(p, wid, lane);
        else {
            const int k = ph - 1, pair = k / 10, r = k % 10;
            if (r < 6) {
                const int bidx = r / 3, s = r % 3;
                if (s == 0) {
                    pg8::Gemm g{XG + (size_t)bidx * SEQ * DM, (const bf16_t*)(ws + WS_WA_IN) + (size_t)pair * 10240 * 1024, SEQ, 10240, DM};
                    pg8::StaticOrder S; S.init(SEQ, 10240, gridDim.x, blockIdx.x);
                    EpiInA E{QKV, Zb + (size_t)bidx * SEQ * DM, SSQ + (size_t)bidx * SEQ * 16, cosA, sinA, 0.08838834764831845f * LOG2E};
                    pg8::gemm_phase<EpiInA, pg8::StaticOrder, true, true>(lds, g, S, E, tid);
                } else if (s == 1) phase_attnA(p, lds, wid, lane);
                else phase_combineA(p, bidx, tid);
            } else if (r == 7) {
                pg8::Gemm g{XG, (const bf16_t*)(ws + WS_WB_IN) + (size_t)pair * 4096 * 1024, MROWS, 4096, DM};
                pg8::StaticOrder S; S.init(MROWS, 4096, gridDim.x, blockIdx.x);
                EpiInB E{QKV, Zb, SSQ, cosB, sinB, 0.125f * LOG2E};
                pg8::gemm_phase<EpiInB, pg8::StaticOrder, true, true>(lds, g, S, E, tid);
            } else if (r == 8) phase_attnB(p, lds, pair, 2 * pair + 1, tid, wid, lane);
            else {
                const bool isA = (r == 6);
                const int layer = 2 * pair + (isA ? 0 : 1);
                const bf16_t* Wt = (const bf16_t*)(ws + (isA ? WS_WA_OUT : WS_WB_OUT)) + (size_t)pair * 1024 * 1024;
                const float* gnext = isA ? p.b_norm + pair * DM : (layer == 3 ? (const float*)nullptr : p.a_norm + (pair + 1) * DM);
                pg8::Gemm g{Zb, Wt, MROWS, DM, DM};
                pg8::StaticOrder S; S.init(MROWS, DM, gridDim.x, blockIdx.x);
                EpiOut E{(layer == 0) ? p.x : (const float*)p.out, p.out, XG, gnext, SSQ};
                pg8::gemm_phase<EpiOut, pg8::StaticOrder, true, true>(lds, g, S, E, tid);
            }
        }
        if (ph + 1 < hi) grid.sync();
    }
}

constexpr int N_PHASES = 22;
#ifndef MK_PER_PHASE
#define MK_PER_PHASE 0
#endif

extern "C" void kernel_launch(void* const* d_in, const int* in_sizes, int n_in, void* d_out, int out_size, void* d_ws, size_t ws_size, hipStream_t stream) {
    static int grid = 0;
    if (grid == 0) {
        int dev = 0, cus = 0, per_cu = 0;
        hipGetDevice(&dev);
        hipDeviceGetAttribute(&cus, hipDeviceAttributeMultiprocessorCount, dev);
        hipFuncSetAttribute((const void*)fwd_megakernel, hipFuncAttributeMaxDynamicSharedMemorySize, LDS_BYTES);
        hipOccupancyMaxActiveBlocksPerMultiprocessor(&per_cu, (const void*)fwd_megakernel, NTHREADS, LDS_BYTES);
        if (per_cu < 1) { fprintf(stderr, "kernel_launch: occupancy query says %d blocks per CU\n", per_cu); per_cu = 1; }
        (void)hipGetLastError();
        grid = cus * 1;
        if (ws_size < WS_END) { fprintf(stderr, "kernel_launch: workspace too small (%zu < %zu)\n", ws_size, (size_t)WS_END); grid = -1; }
    }
    if (grid < 0) return;
    Params p{};
    p.x = (const float*)d_in[0]; p.a_norm = (const float*)d_in[1]; p.a_w_in = (const float*)d_in[2]; p.a_w_out = (const float*)d_in[3];
    p.b_norm = (const float*)d_in[4]; p.b_w_in = (const float*)d_in[5]; p.b_lambda = (const float*)d_in[6]; p.b_subln = (const float*)d_in[7];
    p.b_w_out = (const float*)d_in[8]; p.final_norm = (const float*)d_in[9];
    p.out = (float*)d_out; p.ws = (unsigned char*)d_ws;
#if MK_PER_PHASE
    for (int ph = 0; ph < N_PHASES; ++ph) {
        p.ph_lo = ph; p.ph_hi = ph + 1;
        hipLaunchKernelGGL(fwd_megakernel, dim3(grid), dim3(NTHREADS), LDS_BYTES, stream, p);
    }
#else
    p.ph_lo = 0; p.ph_hi = N_PHASES;
    void* args[] = {&p};
    hipError_t e = hipLaunchCooperativeKernel((const void*)fwd_megakernel, dim3(grid), dim3(NTHREADS), args, LDS_BYTES, stream);
    if (e != hipSuccess) fprintf(stderr, "cooperative launch failed: %s (grid %d)\n", hipGetErrorString(e), grid);
#endif
}
```

```cpp
#include <hip/hip_runtime.h>
#include <hip/hip_cooperative_groups.h>
#include <cstdio>
#include <cstdint>
namespace cg = cooperative_groups;
namespace pg8 {
#define PG8_LAS __attribute__((address_space(3)))
typedef unsigned short bf16_t;
typedef short bf16x8 __attribute__((ext_vector_type(8)));
typedef float f32x4 __attribute__((ext_vector_type(4)));
typedef unsigned u32x4 __attribute__((ext_vector_type(4)));
constexpr int BM = 256, BK = 64, HALF = 128, HTB = HALF * BK * 2  , STAGE_BYTES = 8 * HTB, NXCD = 8, WGM = 8;

__host__ __device__ __forceinline__ int lds_byte(int r, int c) { const int st = (r >> 4) * 2 + (c >> 5), rr = r & 15, cc = c & 31, ob = rr * 64 + cc * 2; return st * 1024 + (ob ^ (((ob >> 9) & 1) << 5)); }
__host__ __device__ __forceinline__ void stage_rc(int b, int& R, int& C) { const int st = b / 1024, sb = b % 1024, swz = sb ^ (((sb >> 9) & 1) << 5); R = (st >> 1) * 16 + swz / 64; C = (st & 1) * 32 + (swz % 64) / 2; }
__host__ __device__ __forceinline__ int perm32(int rho) { const int n = rho >> 4, i = rho & 15; return 8 * (i >> 2) + 4 * n + (i & 3); }

struct Unit { int pm, pn; };
struct Gemm { const bf16_t* A; const bf16_t* Bt; int M, N, K; };

struct StaticOrder {
    int nM, nN, nwg, G, c;
    __host__ __device__ void init(int M, int N, int G_, int c_) { nM = M / BM; nN = N / BM; nwg = nM * nN; G = G_; c = c_; }
    __host__ __device__ bool next(int i, Unit& u) const {
        const long L = (long)i * G + c; if (L >= nwg) return false;
        int wgid = (int)L; { const int q = nwg / NXCD, r = nwg % NXCD, xcd = wgid % NXCD, off = wgid / NXCD; wgid = (xcd < r ? xcd * (q + 1) : r * (q + 1) + (xcd - r) * q) + off; }
        const int nig = WGM * nN, gid = wgid / nig, fm = gid * WGM, gsz = (nM - fm) < WGM ? (nM - fm) : WGM;
        u.pm = fm + ((wgid % nig) % gsz); u.pn = (wgid % nig) / gsz; return true;
    }
    __device__ __forceinline__ void a_ready(const Unit&) const {}
    __device__ __forceinline__ void done(const Unit&) const {}
};

__device__ __forceinline__ unsigned cvt_pk_bf16(float lo, float hi) { unsigned r; asm volatile("v_cvt_pk_bf16_f32 %0, %1, %2" : "=v"(r) : "v"(lo), "v"(hi)); return r; }
typedef float f32x2 __attribute__((ext_vector_type(2)));
template <class Epi, class Sched, bool ALIGN_EPI = false, bool SP2 = false>
__device__ __forceinline__ void gemm_phase(PG8_LAS unsigned char* lds, const Gemm g, const Sched& S, const Epi& E, const int tid) {
    const int wid = __builtin_amdgcn_readfirstlane(tid >> 6), lane = tid & 63, wr = wid >> 2, wc = wid & 3, fr = lane & 15, fq = lane >> 4;
    const int K = g.K, nt = K / BK;
    unsigned voffA[2], voffB[2];
#pragma unroll
    for (int i = 0; i < 2; ++i) { int R, C; stage_rc(tid * 16 + i * 8192, R, C); const int Rb = Epi::PERM ? ((R & ~31) + perm32(R & 31)) : R;
        voffA[i] = (unsigned)(R * K + C) * 2u; voffB[i] = (unsigned)(Rb * K + C) * 2u; }
    const size_t kstep = (size_t)(BK * 2);
    const size_t hstep = (size_t)HALF * K * 2;
    const size_t tstep = 2 * hstep;
    const unsigned ldsw = (unsigned)wid * 1024u;
    const int aoff = lds_byte(wr * 64 + fr, fq * 8), boff = lds_byte(wc * 32 + fr, fq * 8);
#define PG8_SA(b, h) (((b) * 2 + (h)) * HTB)
#define PG8_SB(b, h) ((4 + (b) * 2 + (h)) * HTB)
#define PG8_STAGE(bufoff, gbase, voff) do { _Pragma("unroll") for (int _i = 0; _i < 2; ++_i) \
        __builtin_amdgcn_global_load_lds((const unsigned*)((const char*)(gbase) + (voff)[_i]), (PG8_LAS unsigned*)(lds + (bufoff) + ldsw + _i * 8192), 16, 0, 0); } while (0)
#define PG8_LDA(dst, b, h) do { _Pragma("unroll") for (int m = 0; m < 4; ++m) _Pragma("unroll") for (int k = 0; k < 2; ++k) dst[m][k] = *(const PG8_LAS bf16x8*)(lds + PG8_SA(b, h) + aoff + m * 2048 + k * 1024); } while (0)
#define PG8_LDB(dst, b, h) do { _Pragma("unroll") for (int n = 0; n < 2; ++n) _Pragma("unroll") for (int k = 0; k < 2; ++k) dst[n][k] = *(const PG8_LAS bf16x8*)(lds + PG8_SB(b, h) + boff + n * 2048 + k * 1024); } while (0)
#define PG8_MMA(ai, bj, At, Bt) do { __builtin_amdgcn_s_setprio(1); _Pragma("unroll") for (int m = 0; m < 4; ++m) _Pragma("unroll") for (int n = 0; n < 2; ++n) _Pragma("unroll") for (int k = 0; k < 2; ++k) \
        acc[ai][bj][m][n] = __builtin_amdgcn_mfma_f32_16x16x32_bf16(Bt[n][k], At[m][k], acc[ai][bj][m][n], 0, 0, 0); __builtin_amdgcn_s_setprio(0); } while (0)
#define PG8_WAIT_V(n) asm volatile("s_waitcnt vmcnt(" #n ")" ::: "memory")
#define PG8_WAIT_L(n) asm volatile("s_waitcnt lgkmcnt(" #n ")" ::: "memory")
#define PG8_BAR __builtin_amdgcn_s_barrier()
#define PG8_SCHED __builtin_amdgcn_sched_barrier(0)
    Unit cur, nxt; int ui = 0;
    if (!S.next(0, cur)) return;
    f32x4 acc[2][2][4][2];
#pragma unroll
    for (int a = 0; a < 2; ++a)
#pragma unroll
        for (int b = 0; b < 2; ++b)
#pragma unroll
            for (int m = 0; m < 4; ++m)
#pragma unroll
                for (int n = 0; n < 2; ++n) acc[a][b][m][n] = (f32x4){0.f, 0.f, 0.f, 0.f};
    bf16x8 At[4][2], B0[2][2], B1[2][2];
    const char* cA = (const char*)g.A + (size_t)cur.pm * tstep; const char* cB = (const char*)g.Bt + (size_t)cur.pn * tstep;
    S.a_ready(cur);
    if constexpr (SP2) {
        PG8_STAGE(PG8_SB(0, 0), cB, voffB); PG8_STAGE(PG8_SB(0, 1), cB + hstep, voffB); PG8_STAGE(PG8_SA(0, 0), cA, voffA); PG8_STAGE(PG8_SA(0, 1), cA + hstep, voffA);
        if (wr == 1) PG8_BAR;
        PG8_WAIT_V(2); PG8_BAR;
        PG8_STAGE(PG8_SB(1, 0), cB + kstep, voffB); PG8_STAGE(PG8_SA(1, 0), cA + kstep, voffA); PG8_STAGE(PG8_SB(1, 1), cB + hstep + kstep, voffB);
        PG8_WAIT_V(6); PG8_BAR;
    } else {
        PG8_STAGE(PG8_SB(0, 0), cB, voffB); PG8_STAGE(PG8_SA(0, 0), cA, voffA); PG8_STAGE(PG8_SB(0, 1), cB + hstep, voffB); PG8_STAGE(PG8_SA(0, 1), cA + hstep, voffA);
        if (wr == 1) PG8_BAR;
        PG8_WAIT_V(4); PG8_BAR;
        PG8_STAGE(PG8_SB(1, 0), cB + kstep, voffB); PG8_STAGE(PG8_SA(1, 0), cA + kstep, voffA); PG8_STAGE(PG8_SB(1, 1), cB + hstep + kstep, voffB);
        PG8_WAIT_V(6); PG8_BAR;
    }
    for (;;) {
        const bool has_next = S.next(ui + 1, nxt);
        const char* nA = has_next ? (const char*)g.A + (size_t)nxt.pm * tstep : cA; const char* nB = has_next ? (const char*)g.Bt + (size_t)nxt.pn * tstep : cB;
        for (int t = 0; t < nt; t += 2) {
            const bool last = (t == nt - 2);
            const char* a1 = cA + (size_t)(t + 1) * kstep;
            const char* a2 = last ? nA : cA + (size_t)(t + 2) * kstep; const char* b2 = last ? nB : cB + (size_t)(t + 2) * kstep;
            const char* a3 = a2 + kstep; const char* b3 = b2 + kstep;
            if (last && has_next) S.a_ready(nxt);
            if constexpr (SP2) {
            PG8_LDB(B0, 0, 0); PG8_LDB(B1, 0, 1); PG8_SCHED; PG8_LDA(At, 0, 0); PG8_STAGE(PG8_SA(1, 1), a1 + hstep, voffA);
            PG8_WAIT_V(8); PG8_WAIT_L(0); PG8_BAR; PG8_MMA(0, 0, At, B0); PG8_MMA(0, 1, At, B1); PG8_BAR; PG8_SCHED;
            PG8_LDA(At, 0, 1); PG8_STAGE(PG8_SB(0, 0), b2, voffB); PG8_STAGE(PG8_SB(0, 1), b2 + hstep, voffB); PG8_STAGE(PG8_SA(0, 0), a2, voffA);
            PG8_WAIT_V(8); PG8_WAIT_L(0); PG8_BAR; PG8_MMA(1, 0, At, B0); PG8_MMA(1, 1, At, B1); PG8_BAR; PG8_SCHED;
            PG8_LDB(B0, 1, 0); PG8_LDB(B1, 1, 1); PG8_SCHED; PG8_LDA(At, 1, 0); PG8_STAGE(PG8_SA(0, 1), a2 + hstep, voffA);
            PG8_WAIT_V(8); PG8_WAIT_L(0); PG8_BAR; PG8_MMA(0, 0, At, B0); PG8_MMA(0, 1, At, B1); PG8_BAR; PG8_SCHED;
            PG8_LDA(At, 1, 1); PG8_STAGE(PG8_SB(1, 0), b3, voffB); PG8_STAGE(PG8_SB(1, 1), b3 + hstep, voffB); PG8_STAGE(PG8_SA(1, 0), a3, voffA);
            PG8_WAIT_V(8); PG8_WAIT_L(0); PG8_BAR; PG8_MMA(1, 0, At, B0); PG8_MMA(1, 1, At, B1); PG8_BAR; PG8_SCHED;
            } else {
            PG8_LDB(B0, 0, 0); PG8_SCHED; PG8_LDA(At, 0, 0); PG8_STAGE(PG8_SA(1, 1), a1 + hstep, voffA);
            PG8_WAIT_L(8); PG8_BAR; PG8_WAIT_L(0); PG8_MMA(0, 0, At, B0); PG8_BAR; PG8_SCHED;
            PG8_LDB(B1, 0, 1); PG8_STAGE(PG8_SB(0, 0), b2, voffB);
            PG8_BAR; PG8_WAIT_L(0); PG8_MMA(0, 1, At, B1); PG8_BAR;
            PG8_LDA(At, 0, 1); PG8_STAGE(PG8_SA(0, 0), a2, voffA);
            PG8_BAR; PG8_WAIT_L(0); PG8_MMA(1, 0, At, B0); PG8_BAR; PG8_SCHED;
            PG8_STAGE(PG8_SB(0, 1), b2 + hstep, voffB);
            PG8_WAIT_V(6); PG8_BAR; PG8_MMA(1, 1, At, B1); PG8_BAR;
            PG8_LDB(B0, 1, 0); PG8_SCHED; PG8_LDA(At, 1, 0); PG8_STAGE(PG8_SA(0, 1), a2 + hstep, voffA);
            PG8_WAIT_L(8); PG8_BAR; PG8_WAIT_L(0); PG8_MMA(0, 0, At, B0); PG8_BAR; PG8_SCHED;
            PG8_LDB(B1, 1, 1); PG8_STAGE(PG8_SB(1, 0), b3, voffB);
            PG8_BAR; PG8_WAIT_L(0); PG8_MMA(0, 1, At, B1); PG8_BAR;
            PG8_LDA(At, 1, 1); PG8_STAGE(PG8_SA(1, 0), a3, voffA);
            PG8_BAR; PG8_WAIT_L(0); PG8_MMA(1, 0, At, B0); PG8_BAR; PG8_SCHED;
            PG8_STAGE(PG8_SB(1, 1), b3 + hstep, voffB);
            PG8_WAIT_V(6); PG8_BAR; PG8_MMA(1, 1, At, B1); PG8_BAR;
            }
        }
        if constexpr (ALIGN_EPI) { if (wr == 0) PG8_BAR; }
        if constexpr (!Epi::AFTER_DRAIN) { E(acc, cur, wr, wc, fr, fq); S.done(cur); }
        if (!has_next) break;
#pragma unroll
        for (int a = 0; a < 2; ++a)
#pragma unroll
            for (int b = 0; b < 2; ++b)
#pragma unroll
                for (int m = 0; m < 4; ++m)
#pragma unroll
                    for (int n = 0; n < 2; ++n) acc[a][b][m][n] = (f32x4){0.f, 0.f, 0.f, 0.f};
        cur = nxt; cA = nA; cB = nB; ++ui;
        if constexpr (ALIGN_EPI) { if (wr == 1) PG8_BAR; }
    }
    PG8_WAIT_V(0);
    if constexpr (!ALIGN_EPI) { if (wr == 0) PG8_BAR; }
    PG8_BAR;
    if constexpr (Epi::AFTER_DRAIN) { E.fused(acc, cur, wr, wc, fr, fq, lds, wid, lane); S.done(cur); }
#undef PG8_SA
#undef PG8_SB
#undef PG8_STAGE
#undef PG8_LDA
#undef PG8_LDB
#undef PG8_MMA
#undef PG8_WAIT_V
#undef PG8_WAIT_L
#undef PG8_BAR
#undef PG8_SCHED
}
}

#define DI __device__ __forceinline__
#define LAS __attribute__((address_space(3)))
typedef unsigned short bf16_t;
typedef short bf16x8 __attribute__((ext_vector_type(8)));
typedef short s16x4 __attribute__((ext_vector_type(4)));
typedef float f32x4 __attribute__((ext_vector_type(4)));
typedef float f32x16 __attribute__((ext_vector_type(16)));
typedef unsigned u32x4 __attribute__((ext_vector_type(4)));
typedef unsigned u32x2 __attribute__((ext_vector_type(2)));
typedef float f32x2_t __attribute__((ext_vector_type(2)));
typedef __bf16 bf16x2_t __attribute__((ext_vector_type(2)));
typedef short v4i16_t __attribute__((ext_vector_type(4)));

constexpr int SEQ = 8192, DM = 1024, MROWS = 16384;
constexpr int NWAVES = 8, NTHREADS = 512;
constexpr int LDS_BYTES = 155648;
constexpr float EPS = 1e-6f;
constexpr float LOG2E = 1.4426950408889634f, LN2 = 0.6931471805599453f;
constexpr float NEGB = -1e30f;

constexpr size_t MiB = 1u << 20;
constexpr size_t WS_WA_IN = 0, WS_WB_IN = 40 * MiB, WS_WA_OUT = 56 * MiB, WS_WB_OUT = 60 * MiB;
constexpr size_t WS_XG = 64 * MiB, WS_Z = 96 * MiB, WS_QKV = 128 * MiB;
constexpr size_t WS_SSQ = 272 * MiB, WS_LSE = 273 * MiB, WS_ROPE = 274 * MiB, WS_BAR = 276 * MiB, WS_END = 277 * MiB;

struct Params {
    const float* x; const float* a_norm; const float* a_w_in; const float* a_w_out;
    const float* b_norm; const float* b_w_in; const float* b_lambda; const float* b_subln; const float* b_w_out; const float* final_norm;
    float* out; unsigned char* ws; int ph_lo, ph_hi;
};

DI unsigned cvtpk(float lo, float hi) { f32x2_t v = {lo, hi}; bf16x2_t b = __builtin_convertvector(v, bf16x2_t); return __builtin_bit_cast(unsigned, b); }
DI float bf2f(unsigned short b) { return __uint_as_float(((unsigned)b) << 16); }
DI int crow(int r, int hi) { return (r & 3) + 8 * (r >> 2) + 4 * hi; }
DI s16x4 vtr(const LAS char* p) { return __builtin_bit_cast(s16x4, __builtin_amdgcn_ds_read_tr16_b64_v4i16((LAS v4i16_t*)p)); }
DI float fexp2(float x) { return __builtin_amdgcn_exp2f(x); }
DI float silu(float z) { return z / (1.f + __expf(-z)); }
DI float wave_sum(float v) {
#pragma unroll
    for (int o = 1; o < 64; o <<= 1) v += __shfl_xor(v, o);
    return v;
}
#define MFMA32(a, b, c) __builtin_amdgcn_mfma_f32_32x32x16_bf16((a), (b), (c), 0, 0, 0)

using pg8::Unit;
struct EpiInA {
    static constexpr bool PERM = true, AFTER_DRAIN = false;
    bf16_t* qkv; bf16_t* z; const float* ssq; const float* cs; const float* sn; float qscale;
    DI void operator()(const f32x4 (&acc)[2][2][4][2], const Unit& u, int wr, int wc, int fr, int fq) const {
        const int ct = u.pn; bf16_t* base; int kind;
        if (ct < 36) { const int g = ct / 12, t = (ct % 12) >> 2; kind = t; base = qkv + (size_t)(g * 3 + t) * ((size_t)SEQ * DM) + (ct & 3) * 256; }
        else { kind = 3; base = z + (ct - 36) * 256; }
        const bool rot = (kind < 2) && (wc == 0);
        const float osc = (kind == 0) ? qscale : 1.f;
#pragma unroll
        for (int ai = 0; ai < 2; ++ai)
#pragma unroll
            for (int m = 0; m < 4; ++m) {
                const int row = u.pm * 256 + ai * 128 + wr * 64 + m * 16 + fr;
                const f32x4* sp = (const f32x4*)(ssq + (size_t)row * 16);
                const f32x4 pa = sp[0], pb = sp[1], pc = sp[2], pd = sp[3];
                const float ss = (((pa.x + pa.y) + (pa.z + pa.w)) + ((pb.x + pb.y) + (pb.z + pb.w))) + (((pc.x + pc.y) + (pc.z + pc.w)) + ((pd.x + pd.y) + (pd.z + pd.w)));
                const float rs = 1.0f / sqrtf(ss * (1.0f / DM) + EPS);
                f32x4 c0 = {1.f, 1.f, 1.f, 1.f}, c1 = c0, s0 = {0.f, 0.f, 0.f, 0.f}, s1 = s0;
                if (rot) { const int ib = row * 16 + 8 * (fq & 1); c0 = *(const f32x4*)(cs + ib); c1 = *(const f32x4*)(cs + ib + 4); s0 = *(const f32x4*)(sn + ib); s1 = *(const f32x4*)(sn + ib + 4);
                           if (fq < 2) { s0 = -s0; s1 = -s1; } }
#pragma unroll
                for (int bj = 0; bj < 2; ++bj) {
                    f32x4 v0 = acc[ai][bj][m][0] * rs, v1 = acc[ai][bj][m][1] * rs;
                    if (rot) {
                        f32x4 p0, p1;
#pragma unroll
                        for (int j = 0; j < 4; ++j) { p0[j] = __shfl_xor(v0[j], 32); p1[j] = __shfl_xor(v1[j], 32); }
                        v0 = v0 * c0 + p0 * s0; v1 = v1 * c1 + p1 * s1;
                    }
                    v0 = v0 * osc; v1 = v1 * osc;
                    u32x4 w; w.x = cvtpk(v0[0], v0[1]); w.y = cvtpk(v0[2], v0[3]); w.z = cvtpk(v1[0], v1[1]); w.w = cvtpk(v1[2], v1[3]);
                    *(u32x4*)(base + (size_t)row * DM + bj * 128 + wc * 32 + 8 * fq) = w;
                }
            }
    }
};
struct EpiInB {
    static constexpr bool PERM = true, AFTER_DRAIN = false;
    bf16_t* qkv; bf16_t* z; const float* ssq; const float* cs; const float* sn; float qscale;
    DI void operator()(const f32x4 (&acc)[2][2][4][2], const Unit& u, int wr, int wc, int fr, int fq) const {
        const int ct = u.pn; const int kind = ct >> 2;
        bf16_t* base = (kind < 3 ? qkv + (size_t)kind * ((size_t)MROWS * DM) : z) + (ct & 3) * 256;
        const bool rot = (kind < 2) && ((wc & 1) == 0);
        const float osc = (kind == 0) ? qscale : 1.f;
#pragma unroll
        for (int ai = 0; ai < 2; ++ai)
#pragma unroll
            for (int m = 0; m < 4; ++m) {
                const int row = u.pm * 256 + ai * 128 + wr * 64 + m * 16 + fr;
                const f32x4* sp = (const f32x4*)(ssq + (size_t)row * 16);
                const f32x4 pa = sp[0], pb = sp[1], pc = sp[2], pd = sp[3];
                const float ss = (((pa.x + pa.y) + (pa.z + pa.w)) + ((pb.x + pb.y) + (pb.z + pb.w))) + (((pc.x + pc.y) + (pc.z + pc.w)) + ((pd.x + pd.y) + (pd.z + pd.w)));
                const float rs = 1.0f / sqrtf(ss * (1.0f / DM) + EPS);
                f32x4 c0 = {1.f, 1.f, 1.f, 1.f}, c1 = c0, s0 = {0.f, 0.f, 0.f, 0.f}, s1 = s0;
                if (rot && fq < 2) { const int ib = (row & (SEQ - 1)) * 8; c0 = *(const f32x4*)(cs + ib); c1 = *(const f32x4*)(cs + ib + 4); s0 = *(const f32x4*)(sn + ib); s1 = *(const f32x4*)(sn + ib + 4);
                                     if (fq == 0) { s0 = -s0; s1 = -s1; } }
#pragma unroll
                for (int bj = 0; bj < 2; ++bj) {
                    f32x4 v0 = acc[ai][bj][m][0] * rs, v1 = acc[ai][bj][m][1] * rs;
                    if (rot) {
                        f32x4 p0, p1;
#pragma unroll
                        for (int j = 0; j < 4; ++j) { p0[j] = __shfl_xor(v0[j], 16); p1[j] = __shfl_xor(v1[j], 16); }
                        v0 = v0 * c0 + p0 * s0; v1 = v1 * c1 + p1 * s1;
                    }
                    v0 = v0 * osc; v1 = v1 * osc;
                    u32x4 w; w.x = cvtpk(v0[0], v0[1]); w.y = cvtpk(v0[2], v0[3]); w.z = cvtpk(v1[0], v1[1]); w.w = cvtpk(v1[2], v1[3]);
                    *(u32x4*)(base + (size_t)row * DM + bj * 128 + wc * 32 + 8 * fq) = w;
                }
            }
    }
};
struct EpiOut {
    static constexpr bool PERM = false, AFTER_DRAIN = false;
    const float* xin; float* xout; bf16_t* xg; const float* gnext; float* ssq;
    DI void operator()(const f32x4 (&acc)[2][2][4][2], const Unit& u, int wr, int wc, int fr, int fq) const {
#pragma unroll
        for (int ai = 0; ai < 2; ++ai)
#pragma unroll
            for (int m = 0; m < 4; ++m) {
                const int row = u.pm * 256 + ai * 128 + wr * 64 + m * 16 + fr;
                float ss = 0.f;
#pragma unroll
                for (int bj = 0; bj < 2; ++bj)
#pragma unroll
                    for (int n = 0; n < 2; ++n) {
                        const int col = u.pn * 256 + bj * 128 + wc * 32 + n * 16 + 4 * fq;
                        const size_t off = (size_t)row * DM + col;
                        const f32x4 v = *(const f32x4*)(xin + off) + acc[ai][bj][m][n];
                        *(f32x4*)(xout + off) = v;
                        ss += (v.x * v.x + v.y * v.y) + (v.z * v.z + v.w * v.w);
                        if (gnext) { const f32x4 g4 = *(const f32x4*)(gnext + col); u32x2 w; w.x = cvtpk(v.x * g4.x, v.y * g4.y); w.y = cvtpk(v.z * g4.z, v.w * g4.w); *(u32x2*)(xg + off) = w; }
                    }
                ss += __shfl_xor(ss, 16); ss += __shfl_xor(ss, 32);
                if (fq == 0) ssq[(size_t)row * 16 + u.pn * 4 + wc] = ss;
            }
    }
};

DI unsigned f2bf(float f) { unsigned u = __builtin_bit_cast(unsigned, f); return (u + 0x7fffu + ((u >> 16) & 1u)) >> 16; }
DI unsigned pk2(float lo, float hi) { return f2bf(lo) | (f2bf(hi) << 16); }
DI void transpose_item(const float* W, int K, int N, bf16_t* WT, LAS float* scr, int item, int lane) {
    const int nblk = N / 32, kb = item / nblk, nb = item % nblk, k0 = 64 * kb, n0 = 32 * nb;
#pragma unroll 8
    for (int i = 0; i < 32; ++i) { const int kk = 2 * i + (lane >> 5); scr[kk * 33 + (lane & 31)] = W[(size_t)(k0 + kk) * N + n0 + (lane & 31)]; }
    asm volatile("s_waitcnt lgkmcnt(0)" ::: "memory");
    const int c = lane & 7;
#pragma unroll
    for (int j = 0; j < 4; ++j) { const int n = (lane >> 3) + 8 * j; const LAS float* s = scr + (8 * c) * 33 + n;
        u32x4 o; o.x = pk2(s[0 * 33], s[1 * 33]); o.y = pk2(s[2 * 33], s[3 * 33]); o.z = pk2(s[4 * 33], s[5 * 33]); o.w = pk2(s[6 * 33], s[7 * 33]);
        *(u32x4*)(WT + (size_t)(n0 + n) * K + k0 + 8 * c) = o; }
    asm volatile("s_waitcnt lgkmcnt(0)" ::: "memory");
}

__constant__ float ROPE_INV[16] = {1.0f, 0.44036662578582764f, 0.193922758102417f, 0.08539710193872452f, 0.03760603070259094f, 0.016560440883040428f, 0.00729266507551074f, 0.0032114461064338684f,
                                   0.001414213445968926f, 0.0006227724370546639f, 0.00027424818836152554f, 0.00012076974235242233f, 5.318296462064609e-05f, 2.3419997887685895e-05f, 1.0313385246263351e-05f, 4.541670477919979e-06f};
DI void phase_prologue(const Params& p, LAS unsigned char* lds, int tid, int wid, int lane) {
    unsigned char* ws = p.ws;
    LAS float* scr = (LAS float*)(lds + wid * 16384);
    const int gw = blockIdx.x * NWAVES + wid, NGW = gridDim.x * NWAVES;
    constexpr int I_AIN = 16 * 320, I_OUT = 16 * 32, I_BIN = 16 * 128, PER_J = I_AIN + 2 * I_OUT + I_BIN;
    for (int it = gw; it < 2 * PER_J; it += NGW) {
        const int j = it / PER_J; int r = it % PER_J;
        if (r < I_AIN) { transpose_item(p.a_w_in + (size_t)j * 1024 * 10240, 1024, 10240, (bf16_t*)(ws + WS_WA_IN) + (size_t)j * 10240 * 1024, scr, r, lane); continue; } r -= I_AIN;
        if (r < I_OUT) { transpose_item(p.a_w_out + (size_t)j * 1024 * 1024, 1024, 1024, (bf16_t*)(ws + WS_WA_OUT) + (size_t)j * 1024 * 1024, scr, r, lane); continue; } r -= I_OUT;
        if (r < I_BIN) { transpose_item(p.b_w_in + (size_t)j * 1024 * 4096, 1024, 4096, (bf16_t*)(ws + WS_WB_IN) + (size_t)j * 4096 * 1024, scr, r, lane); continue; } r -= I_BIN;
        transpose_item(p.b_w_out + (size_t)j * 1024 * 1024, 1024, 1024, (bf16_t*)(ws + WS_WB_OUT) + (size_t)j * 1024 * 1024, scr, r, lane);
    }
    bf16_t* xg = (bf16_t*)(ws + WS_XG); float* ssq = (float*)(ws + WS_SSQ);
    for (int m = gw; m < MROWS; m += NGW) {
        const f32x4* xr = (const f32x4*)(p.x + (size_t)m * DM) + lane; const f32x4* gr = (const f32x4*)p.a_norm + lane;
        float s = 0.f;
#pragma unroll
        for (int j = 0; j < 4; ++j) { const f32x4 v = xr[64 * j], g = gr[64 * j]; s += (v.x * v.x + v.y * v.y) + (v.z * v.z + v.w * v.w);
            u32x2 w; w.x = cvtpk(v.x * g.x, v.y * g.y); w.y = cvtpk(v.z * g.z, v.w * g.w); *((u32x2*)(xg + (size_t)m * DM) + lane + 64 * j) = w; }
        s = wave_sum(s);
        if (lane < 16) ssq[(size_t)m * 16 + lane] = (lane == 0) ? s : 0.f;
    }
    float* cosA = (float*)(ws + WS_ROPE); float* sinA = cosA + SEQ * 16; float* cosB = sinA + SEQ * 16; float* sinB = cosB + SEQ * 8;
    for (int idx = blockIdx.x * NTHREADS + tid; idx < SEQ * 24; idx += gridDim.x * NTHREADS) {
        int pos, i, rotd; float* cd; float* sd;
        if (idx < SEQ * 16) { pos = idx >> 4; i = idx & 15; rotd = 32; cd = cosA + idx; sd = sinA + idx; }
        else { const int k = idx - SEQ * 16; pos = k >> 3; i = k & 7; rotd = 16; cd = cosB + k; sd = sinB + k; }
        const float inv = ROPE_INV[(rotd == 32) ? i : 2 * i];
        const float ang = (float)pos * inv;
        const double rev = (double)ang * 0.15915494309189535;
        const double fr = rev - rint(rev);
        *cd = __builtin_amdgcn_cosf((float)fr); *sd = __builtin_amdgcn_sinf((float)fr);
    }
}

constexpr int AW_K = 0, AW_V = 8704, AW_BYTES = 18944;
DI void attnA_item(LAS char* wl, bf16_t* Qb, const bf16_t* Kb, const bf16_t* Vb, float* lse, int r, int rho, int c, int h, int lane, bool dry) {
    const int q = lane & 31, hh = lane >> 5, lr = lane >> 4, lc = lane & 15;
    const int tq = rho + r * (32 * c + q);
    bf16_t* Qrow = Qb + (size_t)tq * DM + h * 128;
    bf16x8 qf[8];
#pragma unroll
    for (int st = 0; st < 8; ++st) qf[st] = *(const bf16x8*)(Qrow + 16 * st + 8 * hh);
    f32x16 o[4];
#pragma unroll
    for (int db = 0; db < 4; ++db)
#pragma unroll
        for (int i = 0; i < 16; ++i) o[db][i] = 0.f;
    float m_run = NEGB, l_run = 0.f;
    const int t_lo = (c - 4 > 0) ? c - 4 : 0;
    u32x4 kreg[8], vreg[8];
    {
        const size_t tok0 = (size_t)(rho + r * (32 * t_lo + lr));
#pragma unroll
        for (int it = 0; it < 8; ++it) { const size_t off = (tok0 + (size_t)r * 4 * it) * DM + h * 128 + lc * 8; kreg[it] = *(const u32x4*)(Kb + off); vreg[it] = *(const u32x4*)(Vb + off); }
    }
    const LAS char* vb = wl + AW_V + (4 * hh + (lc >> 2)) * 320 + (lr & 1) * 32 + (lane & 3) * 8;
    for (int t = t_lo; t <= c; ++t) {
#pragma unroll
        for (int it = 0; it < 8; ++it) { *(LAS u32x4*)(wl + AW_K + (4 * it + lr) * 272 + lc * 16) = kreg[it]; *(LAS u32x4*)(wl + AW_V + (4 * it + lr) * 320 + lc * 16) = vreg[it]; }
        if (t < c) {
            const size_t tok0 = (size_t)(rho + r * (32 * (t + 1) + lr));
#pragma unroll
            for (int it = 0; it < 8; ++it) { const size_t off = (tok0 + (size_t)r * 4 * it) * DM + h * 128 + lc * 8; kreg[it] = *(const u32x4*)(Kb + off); vreg[it] = *(const u32x4*)(Vb + off); }
        }
        f32x16 s;
#pragma unroll
        for (int i = 0; i < 16; ++i) s[i] = 0.f;
#pragma unroll
        for (int st = 0; st < 8; ++st) { const bf16x8 a = *(const LAS bf16x8*)(wl + AW_K + q * 272 + st * 32 + hh * 16); s = MFMA32(a, qf[st], s); }
        if (t == c) {
#pragma unroll
            for (int i = 0; i < 16; ++i) if (crow(i, hh) > q) s[i] = NEGB;
        }
        if (t == c - 4) {
#pragma unroll
            for (int i = 0; i < 16; ++i) if (crow(i, hh) < q) s[i] = NEGB;
        }
        float mx = s[0];
#pragma unroll
        for (int i = 1; i < 16; ++i) mx = fmaxf(mx, s[i]);
        mx = fmaxf(mx, __shfl_xor(mx, 32));
        const float m_new = fmaxf(m_run, mx);
        const float alpha = fexp2(m_run - m_new);
        m_run = m_new;
        float ps = 0.f;
#pragma unroll
        for (int i = 0; i < 16; ++i) { s[i] = fexp2(s[i] - m_new); ps += s[i]; }
        l_run = l_run * alpha + ps;
#pragma unroll
        for (int db = 0; db < 4; ++db)
#pragma unroll
            for (int i = 0; i < 16; ++i) o[db][i] *= alpha;
        bf16x8 pf[2];
#pragma unroll
        for (int s2 = 0; s2 < 2; ++s2) { u32x4 w; w.x = cvtpk(s[8 * s2], s[8 * s2 + 1]); w.y = cvtpk(s[8 * s2 + 2], s[8 * s2 + 3]); w.z = cvtpk(s[8 * s2 + 4], s[8 * s2 + 5]); w.w = cvtpk(s[8 * s2 + 6], s[8 * s2 + 7]); pf[s2] = __builtin_bit_cast(bf16x8, w); }
#pragma unroll
        for (int db = 0; db < 4; ++db)
#pragma unroll
            for (int s2 = 0; s2 < 2; ++s2) {
                const s16x4 lo = vtr(vb + (16 * s2) * 320 + db * 64), hi = vtr(vb + (16 * s2 + 8) * 320 + db * 64);
                const bf16x8 a = (bf16x8){lo[0], lo[1], lo[2], lo[3], hi[0], hi[1], hi[2], hi[3]};
                o[db] = MFMA32(a, pf[s2], o[db]);
            }
    }
    const float l_tot = l_run + __shfl_xor(l_run, 32);
    const float inv = 1.0f / l_tot;
    if (dry) return;
#pragma unroll
    for (int db = 0; db < 4; ++db)
#pragma unroll
        for (int i4 = 0; i4 < 4; ++i4) {
            u32x2 w; w.x = cvtpk(o[db][4 * i4] * inv, o[db][4 * i4 + 1] * inv); w.y = cvtpk(o[db][4 * i4 + 2] * inv, o[db][4 * i4 + 3] * inv);
            *(u32x2*)(Qrow + 32 * db + 8 * i4 + 4 * hh) = w;
        }
    if (hh == 0) lse[(size_t)tq * 8 + h] = (m_run + __log2f(l_tot)) * LN2;
}

DI void phase_attnA(const Params& p, LAS unsigned char* lds, int wid, int lane, bool dry) {
    bf16_t* qkv = (bf16_t*)(p.ws + WS_QKV); float* lse = (float*)(p.ws + WS_LSE);
    LAS char* wl = (LAS char*)lds + wid * AW_BYTES;
    const int gw = blockIdx.x * NWAVES + wid, NGW = gridDim.x * NWAVES;
    for (int id = gw; id < 3 * 2048; id += NGW) {
        const int g = id >> 11, rem = id & 2047, h = rem >> 8, cc = rem & 255;
        const int r = (g == 0) ? 1 : (g == 1) ? 4 : 16;
        const int cpr = 256 / r;
        const int rho = cc / cpr, c = cc % cpr;
        bf16_t* Qb = qkv + (size_t)(g * 3 + 0) * ((size_t)SEQ * DM);
        const bf16_t* Kb = qkv + (size_t)(g * 3 + 1) * ((size_t)SEQ * DM);
        const bf16_t* Vb = qkv + (size_t)(g * 3 + 2) * ((size_t)SEQ * DM);
        attnA_item(wl, Qb, Kb, Vb, lse + (size_t)g * SEQ * 8, r, rho, c, h, lane, dry);
    }
}

DI void phase_combineA(const Params& p, int bidx, int tid) {
    const bf16_t* qkv = (const bf16_t*)(p.ws + WS_QKV); const float* lse = (const float*)(p.ws + WS_LSE);
    bf16_t* zb = (bf16_t*)(p.ws + WS_Z) + (size_t)bidx * SEQ * DM;
    for (int idx = blockIdx.x * NTHREADS + tid; idx < SEQ * 128; idx += gridDim.x * NTHREADS) {
        const int row = idx >> 7, ch = idx & 127, head = ch >> 4;
        const float l0 = lse[(size_t)row * 8 + head], l1 = lse[(size_t)(SEQ + row) * 8 + head], l2 = lse[(size_t)(2 * SEQ + row) * 8 + head];
        const float mx = fmaxf(l0, fmaxf(l1, l2));
        float e0 = __expf(l0 - mx), e1 = __expf(l1 - mx), e2 = __expf(l2 - mx);
        const float inv = 1.0f / (e0 + e1 + e2); e0 *= inv; e1 *= inv; e2 *= inv;
        const size_t off = (size_t)row * DM + ch * 8;
        const u32x4 a0 = *(const u32x4*)(qkv + off), a1 = *(const u32x4*)(qkv + (size_t)3 * SEQ * DM + off), a2 = *(const u32x4*)(qkv + (size_t)6 * SEQ * DM + off);
        const u32x4 zz = *(const u32x4*)(zb + off);
        u32x4 w;
#pragma unroll
        for (int k = 0; k < 4; ++k) {
            const float o_lo = e0 * __uint_as_float(a0[k] << 16) + e1 * __uint_as_float(a1[k] << 16) + e2 * __uint_as_float(a2[k] << 16);
            const float o_hi = e0 * __uint_as_float(a0[k] & 0xffff0000u) + e1 * __uint_as_float(a1[k] & 0xffff0000u) + e2 * __uint_as_float(a2[k] & 0xffff0000u);
            const float z_lo = __uint_as_float(zz[k] << 16), z_hi = __uint_as_float(zz[k] & 0xffff0000u);
            w[k] = cvtpk(o_lo * silu(z_lo), o_hi * silu(z_hi));
        }
        *(u32x4*)(zb + off) = w;
    }
}

constexpr int BB_BUF = 37888, BB_V = 17408, BB_EX = 75776;
DI void attnB_unit(LAS char* lds, const bf16_t* Q, const bf16_t* K, const bf16_t* V, bf16_t* Z, const float* subln, int b, int h, int qb, float lam, float oscale, int tid, int wid, int lane, bool dry) {
    const int strm = wid >> 2, wq = wid & 3, q = lane & 31, hh = lane >> 5;
    const int q0 = qb * 128 + wq * 32;
    const size_t rowbase = (size_t)b * SEQ;
    const bf16_t* Qrow = Q + (rowbase + q0 + q) * DM + h * 128 + strm * 64;
    bf16x8 qf[4];
#pragma unroll
    for (int st = 0; st < 4; ++st) qf[st] = *(const bf16x8*)(Qrow + 16 * st + 8 * hh);
    f32x16 o[4];
#pragma unroll
    for (int db = 0; db < 4; ++db)
#pragma unroll
        for (int i = 0; i < 16; ++i) o[db][i] = 0.f;
    float m_run = NEGB, l_run = 0.f;
    const int NT = 2 * qb + 2;
    const bf16_t* Kg = K + rowbase * DM + h * 128; const bf16_t* Vg = V + rowbase * DM + h * 128;
    const int lrow = tid >> 4, lcc = tid & 15;
    u32x4 kr[2], vr[2];
#define BB_GLOAD(t) do { _Pragma("unroll") for (int i_ = 0; i_ < 2; ++i_) { const size_t off_ = (size_t)(64 * (t) + lrow + 32 * i_) * DM + lcc * 8; kr[i_] = *(const u32x4*)(Kg + off_); vr[i_] = *(const u32x4*)(Vg + off_); } } while (0)
#define BB_LSTORE(buf) do { _Pragma("unroll") for (int i_ = 0; i_ < 2; ++i_) { *(LAS u32x4*)(lds + (buf) * BB_BUF + (lrow + 32 * i_) * 272 + lcc * 16) = kr[i_]; *(LAS u32x4*)(lds + (buf) * BB_BUF + BB_V + (lrow + 32 * i_) * 320 + lcc * 16) = vr[i_]; } } while (0)
    BB_GLOAD(0); BB_LSTORE(0);
    __syncthreads();
    for (int t = 0; t < NT; ++t) {
        const int buf = t & 1;
        if (t + 1 < NT) BB_GLOAD(t + 1);
        if (64 * t <= q0 + 31) {
            const LAS char* kb = lds + buf * BB_BUF;
            const LAS char* vb = kb + BB_V + (4 * hh + ((lane & 15) >> 2)) * 320 + ((lane >> 4) & 1) * 32 + (lane & 3) * 8;
            f32x16 p0, p1;
#pragma unroll
            for (int i = 0; i < 16; ++i) { p0[i] = 0.f; p1[i] = 0.f; }
#pragma unroll
            for (int st = 0; st < 4; ++st) {
                const bf16x8 a0 = *(const LAS bf16x8*)(kb + q * 272 + strm * 128 + st * 32 + hh * 16);
                const bf16x8 a1 = *(const LAS bf16x8*)(kb + (q + 32) * 272 + strm * 128 + st * 32 + hh * 16);
                p0 = MFMA32(a0, qf[st], p0); p1 = MFMA32(a1, qf[st], p1);
            }
            if (64 * t + 63 > q0) {
                const int qrel = q0 + q - 64 * t;
#pragma unroll
                for (int i = 0; i < 16; ++i) { const int kv = crow(i, hh); if (kv > qrel) p0[i] = NEGB; if (kv + 32 > qrel) p1[i] = NEGB; }
            }
            float mx = fmaxf(p0[0], p1[0]);
#pragma unroll
            for (int i = 1; i < 16; ++i) mx = fmaxf(mx, fmaxf(p0[i], p1[i]));
            mx = fmaxf(mx, __shfl_xor(mx, 32));
            const float m_new = fmaxf(m_run, mx);
            const float alpha = fexp2(m_run - m_new);
            m_run = m_new;
            float ps = 0.f;
#pragma unroll
            for (int i = 0; i < 16; ++i) { p0[i] = fexp2(p0[i] - m_new); p1[i] = fexp2(p1[i] - m_new); ps += p0[i] + p1[i]; }
            l_run = l_run * alpha + ps;
#pragma unroll
            for (int db = 0; db < 4; ++db)
#pragma unroll
                for (int i = 0; i < 16; ++i) o[db][i] *= alpha;
            bf16x8 pf[4];
#pragma unroll
            for (int s2 = 0; s2 < 2; ++s2) {
                u32x4 w; w.x = cvtpk(p0[8 * s2], p0[8 * s2 + 1]); w.y = cvtpk(p0[8 * s2 + 2], p0[8 * s2 + 3]); w.z = cvtpk(p0[8 * s2 + 4], p0[8 * s2 + 5]); w.w = cvtpk(p0[8 * s2 + 6], p0[8 * s2 + 7]); pf[s2] = __builtin_bit_cast(bf16x8, w);
                u32x4 x; x.x = cvtpk(p1[8 * s2], p1[8 * s2 + 1]); x.y = cvtpk(p1[8 * s2 + 2], p1[8 * s2 + 3]); x.z = cvtpk(p1[8 * s2 + 4], p1[8 * s2 + 5]); x.w = cvtpk(p1[8 * s2 + 6], p1[8 * s2 + 7]); pf[2 + s2] = __builtin_bit_cast(bf16x8, x);
            }
#pragma unroll
            for (int db = 0; db < 4; ++db)
#pragma unroll
                for (int s2 = 0; s2 < 4; ++s2) {
                    const s16x4 lo = vtr(vb + (16 * s2) * 320 + db * 64), hi = vtr(vb + (16 * s2 + 8) * 320 + db * 64);
                    const bf16x8 a = (bf16x8){lo[0], lo[1], lo[2], lo[3], hi[0], hi[1], hi[2], hi[3]};
                    o[db] = MFMA32(a, pf[s2], o[db]);
                    if (s2 == 3) __builtin_amdgcn_sched_barrier(0);
                }
        }
        if (t + 1 < NT) BB_LSTORE(buf ^ 1);
        __syncthreads();
    }
#undef BB_GLOAD
#undef BB_LSTORE
    const float l_tot = l_run + __shfl_xor(l_run, 32);
    const float inv = 1.0f / l_tot;
    LAS float* ex = (LAS float*)(lds + BB_EX) + wq * 4096;
    if (strm == 1) {
#pragma unroll
        for (int db = 0; db < 4; ++db)
#pragma unroll
            for (int i = 0; i < 16; ++i) ex[(db * 16 + i) * 64 + lane] = o[db][i] * inv;
    }
    __syncthreads();
    if (strm == 0) {
        float ss = 0.f;
#pragma unroll
        for (int db = 0; db < 4; ++db) {
#pragma unroll
            for (int i = 0; i < 16; ++i) { const float d = o[db][i] * inv - lam * ex[(db * 16 + i) * 64 + lane]; o[db][i] = d; ss += d * d; }
            __builtin_amdgcn_sched_barrier(0); }
        ss += __shfl_xor(ss, 32);
        const float rn = (1.0f / sqrtf(ss * (1.0f / 128.0f) + EPS)) * oscale;
        bf16_t* Zrow = Z + (rowbase + q0 + q) * DM + h * 128;
#pragma unroll
        for (int db = 0; db < 4; ++db)
#pragma unroll
            for (int i4 = 0; i4 < 4; ++i4) {
                const int d0 = 32 * db + 8 * i4 + 4 * hh;
                const u32x2 zz = *(const u32x2*)(Zrow + d0);
                const f32x4 sl = *(const f32x4*)(subln + d0);
                const float z0 = __uint_as_float(zz.x << 16), z1 = __uint_as_float(zz.x & 0xffff0000u), z2 = __uint_as_float(zz.y << 16), z3 = __uint_as_float(zz.y & 0xffff0000u);
                u32x2 w; w.x = cvtpk(o[db][4 * i4] * rn * sl.x * silu(z0), o[db][4 * i4 + 1] * rn * sl.y * silu(z1));
                w.y = cvtpk(o[db][4 * i4 + 2] * rn * sl.z * silu(z2), o[db][4 * i4 + 3] * rn * sl.w * silu(z3));
                if (!dry) *(u32x2*)(Zrow + d0) = w;
                __builtin_amdgcn_sched_barrier(0);
            }
    }
}

DI void phase_attnB(const Params& p, LAS unsigned char* lds, int j, int layer, int tid, int wid, int lane, bool dry) {
    const bf16_t* Q = (const bf16_t*)(p.ws + WS_QKV); const bf16_t* K = Q + (size_t)MROWS * DM; const bf16_t* V = K + (size_t)MROWS * DM;
    bf16_t* Z = (bf16_t*)(p.ws + WS_Z);
    const float* lp = p.b_lambda + j * 256;
    const float d1 = wave_sum(lp[lane] * lp[64 + lane]), d2 = wave_sum(lp[128 + lane] * lp[192 + lane]);
    asm volatile("" : "+s"(layer));
    const float lam_init = (layer == 1) ? 0.35550906759096926f : 0.5560582041556006f;
    const float lam = expf(d1) - expf(d2) + lam_init;
    const float oscale = 1.0f - lam_init;
    const float* subln = p.b_subln + j * 128;
    for (int v = blockIdx.x; v < 256; v += gridDim.x) {
        const int bh = v >> 4, s = v & 15;
#pragma unroll 1
        for (int k = 0; k < 4; ++k) {
            const int qb = (k == 0) ? 63 - s : (k == 1) ? 32 + s : (k == 2) ? 31 - s : s;
            attnB_unit((LAS char*)lds, Q, K, V, Z, subln, bh >> 3, bh & 7, qb, lam, oscale, tid, wid, lane, dry);
        }
    }
}

DI void phase_final(const Params& p, int wid, int lane) {
    const int gw = blockIdx.x * NWAVES + wid, NGW = gridDim.x * NWAVES;
    for (int m = gw; m < MROWS; m += NGW) {
        f32x4* xr = (f32x4*)(p.out + (size_t)m * DM) + lane; const f32x4* gr = (const f32x4*)p.final_norm + lane;
        f32x4 v[4]; float s = 0.f;
#pragma unroll
        for (int j = 0; j < 4; ++j) { v[j] = xr[64 * j]; s += (v[j].x * v[j].x + v[j].y * v[j].y) + (v[j].z * v[j].z + v[j].w * v[j].w); }
        const float rs = 1.0f / sqrtf(wave_sum(s) * (1.0f / DM) + EPS);
#pragma unroll
        for (int j = 0; j < 4; ++j) xr[64 * j] = v[j] * rs * gr[64 * j];
    }
}

#define XB_TMO      128
#define XB_XCNT(j)  (256  + 64 * (j))
#define XB_XSUB(j)  (1280 + 64 * (j))
#define XB_XGEN(j)  (2304 + 64 * (j))
#define XB_TOP      3328
#define XB_TOPGEN   3392
#define XCD_BAR_WORDS 3456
#define XB_SPIN_CAP (1u << 18)

__device__ __forceinline__ unsigned xb_ld(unsigned* p)              { return __hip_atomic_load(p, __ATOMIC_RELAXED, __HIP_MEMORY_SCOPE_AGENT); }
__device__ __forceinline__ unsigned xb_add(unsigned* p, unsigned v) { return __hip_atomic_fetch_add(p, v, __ATOMIC_RELAXED, __HIP_MEMORY_SCOPE_AGENT); }
__device__ __forceinline__ unsigned xb_xcc_id() { return (unsigned)__builtin_amdgcn_s_getreg((3 << 11) | 20) & 0xFu; }
#define XB_SPIN(cond, bar) do { unsigned _sp = 0; while (cond) { __builtin_amdgcn_s_sleep(1); \
    if ((++_sp & 255u) == 0u) { if (xb_ld(&(bar)[XB_TMO])) break; if (_sp > XB_SPIN_CAP) { atomicAdd(&(bar)[XB_TMO], 1u); break; } } } } while (0)

struct XcdBarrier {
    unsigned* bar; unsigned x;
    volatile LAS unsigned* st;
};

__device__ __forceinline__ XcdBarrier xcd_barrier_post(unsigned* bar, volatile LAS unsigned* st) {
    XcdBarrier b; b.bar = bar; b.x = xb_xcc_id(); b.st = st;
    if (threadIdx.x == 0) (void)xb_add(&bar[XB_XCNT(b.x)], 1u);
    return b;
}
__device__ __forceinline__ void xcd_barrier_complete(unsigned* bar, unsigned x, unsigned& nloc, unsigned& nx) {
    const unsigned G = gridDim.x * gridDim.y * gridDim.z;
    unsigned sum, cnt, mine, sp = 0u;
    for (;;) {
        sum = 0u; cnt = 0u; mine = 0u;
#pragma unroll
        for (unsigned j = 0; j < 16; ++j) { const unsigned c = xb_ld(&bar[XB_XCNT(j)]); sum += c; cnt += (c > 0u) ? 1u : 0u; mine = (j == x) ? c : mine; }
        if (sum == G) break;
        __builtin_amdgcn_s_sleep(1);
        if ((++sp & 255u) == 0u) { if (xb_ld(&bar[XB_TMO])) break; if (sp > XB_SPIN_CAP) { atomicAdd(&bar[XB_TMO], 1u); break; } }
    }
    nloc = mine > 0u ? mine : 1u; nx = cnt > 0u ? cnt : 1u;
}

__device__ __forceinline__ void xcd_barrier(const XcdBarrier& b) {
    asm volatile("s_waitcnt vmcnt(0)" ::: "memory");
    __syncthreads();
    if (threadIdx.x == 0) {
        unsigned* bar = b.bar;
        __builtin_amdgcn_s_waitcnt(0);
        unsigned nloc = b.st[0], nx = b.st[1];
        if (nloc == 0u) { xcd_barrier_complete(bar, b.x, nloc, nx); b.st[0] = nloc; b.st[1] = nx; }
        const unsigned old = xb_add(&bar[XB_XSUB(b.x)], 1u);
        const unsigned gen = old / nloc;
        if (old + 1u == (gen + 1u) * nloc) {
            __builtin_amdgcn_fence(__ATOMIC_RELEASE, "agent");
            asm volatile("s_waitcnt vmcnt(0)" ::: "memory");
            const unsigned og = xb_add(&bar[XB_TOP], 1u);
            const unsigned tg = og / nx;
            if (og + 1u == (tg + 1u) * nx) xb_add(&bar[XB_TOPGEN], 1u);
            else XB_SPIN(xb_ld(&bar[XB_TOPGEN]) == tg, bar);
            __builtin_amdgcn_fence(__ATOMIC_ACQUIRE, "agent");
            xb_add(&bar[XB_XGEN(b.x)], 1u);
            asm volatile("s_waitcnt vmcnt(0)" ::: "memory");
        } else {
            XB_SPIN(xb_ld(&bar[XB_XGEN(b.x)]) == gen, bar);
            __builtin_amdgcn_fence(__ATOMIC_ACQUIRE, "agent");
            asm volatile("s_waitcnt vmcnt(0)" ::: "memory");
        }
    }
    __syncthreads();
}

#ifndef PROBE_KIND
#define PROBE_KIND -1
#endif
__global__ void __launch_bounds__(NTHREADS, 2) fwd_megakernel(Params p_arg) {
    extern __shared__ __attribute__((aligned(16))) unsigned char lds_raw[];
    LAS unsigned char* lds = (LAS unsigned char*)lds_raw;
    cg::grid_group grid = cg::this_grid();
    const int lo = p_arg.ph_lo, hi = p_arg.ph_hi;
    volatile LAS unsigned* bst = (volatile LAS unsigned*)(lds + LDS_BYTES - 64);
    unsigned* barw = (unsigned*)(p_arg.ws + WS_BAR);
    if (threadIdx.x == 0) { bst[0] = 0u; bst[1] = 0u; }
    if (blockIdx.x == 0) for (int i = threadIdx.x; i < XCD_BAR_WORDS; i += NTHREADS) barw[i] = 0u;
    __syncthreads();
    XcdBarrier xb; xb.bar = barw; xb.x = 0; xb.st = bst;
#pragma unroll 1
    for (int ph = lo; ph < hi; ++ph) {
        int kind;
        if (ph == 0) kind = 0; else if (ph == 21) kind = 7; else { const int r_ = (ph - 1) % 10; kind = (r_ < 6) ? 1 + r_ % 3 : (r_ == 7) ? 4 : (r_ == 8) ? 5 : 6; }
        const int reps = (kind == PROBE_KIND) ? 2 : 1;
#pragma unroll 1
        for (int rep = 0; rep < reps; ++rep) {
        int tid = threadIdx.x; asm volatile("" : "+v"(tid));
#if defined(__HIP_DEVICE_COMPILE__)
        const __attribute__((address_space(4))) Params* pp = (const __attribute__((address_space(4))) Params*)__builtin_amdgcn_kernarg_segment_ptr();
        asm volatile("" : "+s"(pp));
        const Params p = *pp;
#else
        const Params p = p_arg;
#endif
        const int lane = tid & 63, wid = __builtin_amdgcn_readfirstlane(tid >> 6);
        unsigned char* ws = p.ws;
        bf16_t* XG = (bf16_t*)(ws + WS_XG); bf16_t* Zb = (bf16_t*)(ws + WS_Z); bf16_t* QKV = (bf16_t*)(ws + WS_QKV);
        float* SSQ = (float*)(ws + WS_SSQ);
        const float* cosA = (const float*)(ws + WS_ROPE); const float* sinA = cosA + SEQ * 16; const float* cosB = sinA + SEQ * 16; const float* sinB = cosB + SEQ * 8;
        const bool dry = (PROBE_KIND >= 0) && (rep + 1 < reps) && (p.ph_hi < 1000);
        if (ph == 0) phase_prologue(p, lds, tid, wid, lane);
        else if (ph == 21) phase_final(p, wid, lane);
        else {
            const int k = ph - 1, pair = k / 10, r = k % 10;
            if (r < 6) {
                const int bidx = r / 3, s = r % 3;
                if (s == 0) {
                    pg8::Gemm g{XG + (size_t)bidx * SEQ * DM, (const bf16_t*)(ws + WS_WA_IN) + (size_t)pair * 10240 * 1024, SEQ, 10240, DM};
                    pg8::StaticOrder S; S.init(SEQ, 10240, gridDim.x, blockIdx.x);
                    EpiInA E{QKV, Zb + (size_t)bidx * SEQ * DM, SSQ + (size_t)bidx * SEQ * 16, cosA, sinA, 0.08838834764831845f * LOG2E};
                    pg8::gemm_phase<EpiInA, pg8::StaticOrder, true, true>(lds, g, S, E, tid);
                } else if (s == 1) phase_attnA(p, lds, wid, lane, dry);
                else phase_combineA(p, bidx, tid);
            } else if (r == 7) {
                pg8::Gemm g{XG, (const bf16_t*)(ws + WS_WB_IN) + (size_t)pair * 4096 * 1024, MROWS, 4096, DM};
                pg8::StaticOrder S; S.init(MROWS, 4096, gridDim.x, blockIdx.x);
                EpiInB E{QKV, Zb, SSQ, cosB, sinB, 0.125f * LOG2E};
                pg8::gemm_phase<EpiInB, pg8::StaticOrder, true, true>(lds, g, S, E, tid);
            } else if (r == 8) phase_attnB(p, lds, pair, 2 * pair + 1, tid, wid, lane, dry);
            else {
                const bool isA = (r == 6);
                const int layer = 2 * pair + (isA ? 0 : 1);
                const bf16_t* Wt = (const bf16_t*)(ws + (isA ? WS_WA_OUT : WS_WB_OUT)) + (size_t)pair * 1024 * 1024;
                const float* gnext = isA ? p.b_norm + pair * DM : (layer == 3 ? (const float*)nullptr : p.a_norm + (pair + 1) * DM);
                pg8::Gemm g{Zb, Wt, MROWS, DM, DM};
                pg8::StaticOrder S; S.init(MROWS, DM, gridDim.x, blockIdx.x);
                EpiOut E{(layer == 0) ? p.x : (const float*)p.out, p.out, XG, gnext, SSQ};
                pg8::gemm_phase<EpiOut, pg8::StaticOrder, true, true>(lds, g, S, E, tid);
            }
        }
        }
        if (ph + 1 < hi) { if (ph == lo) { grid.sync(); xb = xcd_barrier_post(barw, bst); } else xcd_barrier(xb); }
    }
}

constexpr int N_PHASES = 22;
#ifndef MK_PER_PHASE
#define MK_PER_PHASE 0
#endif

extern "C" void kernel_launch(void* const* d_in, const int* in_sizes, int n_in, void* d_out, int out_size, void* d_ws, size_t ws_size, hipStream_t stream) {
    static int grid = 0;
    if (grid == 0) {
        int dev = 0, cus = 0, per_cu = 0;
        hipGetDevice(&dev);
        hipDeviceGetAttribute(&cus, hipDeviceAttributeMultiprocessorCount, dev);
        hipFuncSetAttribute((const void*)fwd_megakernel, hipFuncAttributeMaxDynamicSharedMemorySize, LDS_BYTES);
        hipOccupancyMaxActiveBlocksPerMultiprocessor(&per_cu, (const void*)fwd_megakernel, NTHREADS, LDS_BYTES);
        if (per_cu < 1) { fprintf(stderr, "kernel_launch: occupancy query says %d blocks per CU\n", per_cu); per_cu = 1; }
        (void)hipGetLastError();
        grid = cus * 1;
        if (ws_size < WS_END) { fprintf(stderr, "kernel_launch: workspace too small (%zu < %zu)\n", ws_size, (size_t)WS_END); grid = -1; }
    }
    if (grid < 0) return;
    Params p{};
    p.x = (const float*)d_in[0]; p.a_norm = (const float*)d_in[1]; p.a_w_in = (const float*)d_in[2]; p.a_w_out = (const float*)d_in[3];
    p.b_norm = (const float*)d_in[4]; p.b_w_in = (const float*)d_in[5]; p.b_lambda = (const float*)d_in[6]; p.b_subln = (const float*)d_in[7];
    p.b_w_out = (const float*)d_in[8]; p.final_norm = (const float*)d_in[9];
    p.out = (float*)d_out; p.ws = (unsigned char*)d_ws;
#if MK_PER_PHASE
    for (int ph = 0; ph < N_PHASES; ++ph) {
        p.ph_lo = ph; p.ph_hi = ph + 1;
        hipLaunchKernelGGL(fwd_megakernel, dim3(grid), dim3(NTHREADS), LDS_BYTES, stream, p);
    }
#else
    p.ph_lo = 0; p.ph_hi = N_PHASES;
    void* args[] = {&p};
    hipError_t e = hipLaunchCooperativeKernel((const void*)fwd_megakernel, dim3(grid), dim3(NTHREADS), args, LDS_BYTES, stream);
    if (e != hipSuccess) fprintf(stderr, "cooperative launch failed: %s (grid %d)\n", hipGetErrorString(e), grid);
#endif
}
```

```cpp
#include <hip/hip_runtime.h>
#include <hip/hip_cooperative_groups.h>
#include <cstdio>
#include <cstdint>
namespace cg = cooperative_groups;
namespace pg8 {
#define PG8_LAS __attribute__((address_space(3)))
typedef unsigned short bf16_t;
typedef short bf16x8 __attribute__((ext_vector_type(8)));
typedef float f32x4 __attribute__((ext_vector_type(4)));
typedef unsigned u32x4 __attribute__((ext_vector_type(4)));
constexpr int BM = 256, BK = 64, HALF = 128, HTB = HALF * BK * 2  , STAGE_BYTES = 8 * HTB, NXCD = 8, WGM = 8;

__host__ __device__ __forceinline__ int lds_byte(int r, int c) { const int st = (r >> 4) * 2 + (c >> 5), rr = r & 15, cc = c & 31, ob = rr * 64 + cc * 2; return st * 1024 + (ob ^ (((ob >> 9) & 1) << 5)); }
__host__ __device__ __forceinline__ void stage_rc(int b, int& R, int& C) { const int st = b / 1024, sb = b % 1024, swz = sb ^ (((sb >> 9) & 1) << 5); R = (st >> 1) * 16 + swz / 64; C = (st & 1) * 32 + (swz % 64) / 2; }
__host__ __device__ __forceinline__ int perm32(int rho) { const int n = rho >> 4, i = rho & 15; return 8 * (i >> 2) + 4 * n + (i & 3); }

struct Unit { int pm, pn; };
struct Gemm { const bf16_t* A; const bf16_t* Bt; int M, N, K; };

struct StaticOrder {
    int nM, nN, nwg, G, c;
    __host__ __device__ void init(int M, int N, int G_, int c_) { nM = M / BM; nN = N / BM; nwg = nM * nN; G = G_; c = c_; }
    __host__ __device__ bool next(int i, Unit& u) const {
        const long L = (long)i * G + c; if (L >= nwg) return false;
        int wgid = (int)L; { const int q = nwg / NXCD, r = nwg % NXCD, xcd = wgid % NXCD, off = wgid / NXCD; wgid = (xcd < r ? xcd * (q + 1) : r * (q + 1) + (xcd - r) * q) + off; }
        const int nig = WGM * nN, gid = wgid / nig, fm = gid * WGM, gsz = (nM - fm) < WGM ? (nM - fm) : WGM;
        u.pm = fm + ((wgid % nig) % gsz); u.pn = (wgid % nig) / gsz; return true;
    }
    __device__ __forceinline__ void a_ready(const Unit&) const {}
    __device__ __forceinline__ void done(const Unit&) const {}
};

__device__ __forceinline__ unsigned cvt_pk_bf16(float lo, float hi) { unsigned r; asm volatile("v_cvt_pk_bf16_f32 %0, %1, %2" : "=v"(r) : "v"(lo), "v"(hi)); return r; }
typedef float f32x2 __attribute__((ext_vector_type(2)));
template <class Epi, class Sched, bool ALIGN_EPI = false, bool SP2 = false>
__device__ __forceinline__ void gemm_phase(PG8_LAS unsigned char* lds, const Gemm g, const Sched& S, const Epi& E, const int tid) {
    const int wid = __builtin_amdgcn_readfirstlane(tid >> 6), lane = tid & 63, wr = wid >> 2, wc = wid & 3, fr = lane & 15, fq = lane >> 4;
    const int K = g.K, nt = K / BK;
    unsigned voffA[2], voffB[2];
#pragma unroll
    for (int i = 0; i < 2; ++i) { int R, C; stage_rc(tid * 16 + i * 8192, R, C); const int Rb = Epi::PERM ? ((R & ~31) + perm32(R & 31)) : R;
        voffA[i] = (unsigned)(R * K + C) * 2u; voffB[i] = (unsigned)(Rb * K + C) * 2u; }
    const size_t kstep = (size_t)(BK * 2);
    const size_t hstep = (size_t)HALF * K * 2;
    const size_t tstep = 2 * hstep;
    const unsigned ldsw = (unsigned)wid * 1024u;
    const int aoff = lds_byte(wr * 64 + fr, fq * 8), boff = lds_byte(wc * 32 + fr, fq * 8);
#define PG8_SA(b, h) (((b) * 2 + (h)) * HTB)
#define PG8_SB(b, h) ((4 + (b) * 2 + (h)) * HTB)
#define PG8_STAGE(bufoff, gbase, voff) do { _Pragma("unroll") for (int _i = 0; _i < 2; ++_i) \
        __builtin_amdgcn_global_load_lds((const unsigned*)((const char*)(gbase) + (voff)[_i]), (PG8_LAS unsigned*)(lds + (bufoff) + ldsw + _i * 8192), 16, 0, 0); } while (0)
#define PG8_LDA(dst, b, h) do { _Pragma("unroll") for (int m = 0; m < 4; ++m) _Pragma("unroll") for (int k = 0; k < 2; ++k) dst[m][k] = *(const PG8_LAS bf16x8*)(lds + PG8_SA(b, h) + aoff + m * 2048 + k * 1024); } while (0)
#define PG8_LDB(dst, b, h) do { _Pragma("unroll") for (int n = 0; n < 2; ++n) _Pragma("unroll") for (int k = 0; k < 2; ++k) dst[n][k] = *(const PG8_LAS bf16x8*)(lds + PG8_SB(b, h) + boff + n * 2048 + k * 1024); } while (0)
#define PG8_MMA(ai, bj, At, Bt) do { __builtin_amdgcn_s_setprio(1); _Pragma("unroll") for (int m = 0; m < 4; ++m) _Pragma("unroll") for (int n = 0; n < 2; ++n) _Pragma("unroll") for (int k = 0; k < 2; ++k) \
        acc[ai][bj][m][n] = __builtin_amdgcn_mfma_f32_16x16x32_bf16(Bt[n][k], At[m][k], acc[ai][bj][m][n], 0, 0, 0); __builtin_amdgcn_s_setprio(0); } while (0)
#define PG8_WAIT_V(n) asm volatile("s_waitcnt vmcnt(" #n ")" ::: "memory")
#define PG8_WAIT_L(n) asm volatile("s_waitcnt lgkmcnt(" #n ")" ::: "memory")
#define PG8_BAR __builtin_amdgcn_s_barrier()
#define PG8_SCHED __builtin_amdgcn_sched_barrier(0)
    Unit cur, nxt; int ui = 0;
    if (!S.next(0, cur)) return;
    f32x4 acc[2][2][4][2];
#pragma unroll
    for (int a = 0; a < 2; ++a)
#pragma unroll
        for (int b = 0; b < 2; ++b)
#pragma unroll
            for (int m = 0; m < 4; ++m)
#pragma unroll
                for (int n = 0; n < 2; ++n) acc[a][b][m][n] = (f32x4){0.f, 0.f, 0.f, 0.f};
    bf16x8 At[4][2], B0[2][2], B1[2][2];
    const char* cA = (const char*)g.A + (size_t)cur.pm * tstep; const char* cB = (const char*)g.Bt + (size_t)cur.pn * tstep;
    S.a_ready(cur);
    if constexpr (SP2) {
        PG8_STAGE(PG8_SB(0, 0), cB, voffB); PG8_STAGE(PG8_SB(0, 1), cB + hstep, voffB); PG8_STAGE(PG8_SA(0, 0), cA, voffA); PG8_STAGE(PG8_SA(0, 1), cA + hstep, voffA);
        if (wr == 1) PG8_BAR;
        PG8_WAIT_V(2); PG8_BAR;
        PG8_STAGE(PG8_SB(1, 0), cB + kstep, voffB); PG8_STAGE(PG8_SA(1, 0), cA + kstep, voffA); PG8_STAGE(PG8_SB(1, 1), cB + hstep + kstep, voffB);
        PG8_WAIT_V(6); PG8_BAR;
    } else {
        PG8_STAGE(PG8_SB(0, 0), cB, voffB); PG8_STAGE(PG8_SA(0, 0), cA, voffA); PG8_STAGE(PG8_SB(0, 1), cB + hstep, voffB); PG8_STAGE(PG8_SA(0, 1), cA + hstep, voffA);
        if (wr == 1) PG8_BAR;
        PG8_WAIT_V(4); PG8_BAR;
        PG8_STAGE(PG8_SB(1, 0), cB + kstep, voffB); PG8_STAGE(PG8_SA(1, 0), cA + kstep, voffA); PG8_STAGE(PG8_SB(1, 1), cB + hstep + kstep, voffB);
        PG8_WAIT_V(6); PG8_BAR;
    }
    for (;;) {
        const bool has_next = S.next(ui + 1, nxt);
        const char* nA = has_next ? (const char*)g.A + (size_t)nxt.pm * tstep : cA; const char* nB = has_next ? (const char*)g.Bt + (size_t)nxt.pn * tstep : cB;
        for (int t = 0; t < nt; t += 2) {
            const bool last = (t == nt - 2);
            const char* a1 = cA + (size_t)(t + 1) * kstep;
            const char* a2 = last ? nA : cA + (size_t)(t + 2) * kstep; const char* b2 = last ? nB : cB + (size_t)(t + 2) * kstep;
            const char* a3 = a2 + kstep; const char* b3 = b2 + kstep;
            if (last && has_next) S.a_ready(nxt);
            if constexpr (SP2) {
            PG8_LDB(B0, 0, 0); PG8_LDB(B1, 0, 1); PG8_SCHED; PG8_LDA(At, 0, 0); PG8_STAGE(PG8_SA(1, 1), a1 + hstep, voffA);
            PG8_WAIT_V(8); PG8_WAIT_L(0); PG8_BAR; PG8_MMA(0, 0, At, B0); PG8_MMA(0, 1, At, B1); PG8_BAR; PG8_SCHED;
            PG8_LDA(At, 0, 1); PG8_STAGE(PG8_SB(0, 0), b2, voffB); PG8_STAGE(PG8_SB(0, 1), b2 + hstep, voffB); PG8_STAGE(PG8_SA(0, 0), a2, voffA);
            PG8_WAIT_V(8); PG8_WAIT_L(0); PG8_BAR; PG8_MMA(1, 0, At, B0); PG8_MMA(1, 1, At, B1); PG8_BAR; PG8_SCHED;
            PG8_LDB(B0, 1, 0); PG8_LDB(B1, 1, 1); PG8_SCHED; PG8_LDA(At, 1, 0); PG8_STAGE(PG8_SA(0, 1), a2 + hstep, voffA);
            PG8_WAIT_V(8); PG8_WAIT_L(0); PG8_BAR; PG8_MMA(0, 0, At, B0); PG8_MMA(0, 1, At, B1); PG8_BAR; PG8_SCHED;
            PG8_LDA(At, 1, 1); PG8_STAGE(PG8_SB(1, 0), b3, voffB); PG8_STAGE(PG8_SB(1, 1), b3 + hstep, voffB); PG8_STAGE(PG8_SA(1, 0), a3, voffA);
            PG8_WAIT_V(8); PG8_WAIT_L(0); PG8_BAR; PG8_MMA(1, 0, At, B0); PG8_MMA(1, 1, At, B1); PG8_BAR; PG8_SCHED;
            } else {
            PG8_LDB(B0, 0, 0); PG8_SCHED; PG8_LDA(At, 0, 0); PG8_STAGE(PG8_SA(1, 1), a1 + hstep, voffA);
            PG8_WAIT_L(8); PG8_BAR; PG8_WAIT_L(0); PG8_MMA(0, 0, At, B0); PG8_BAR; PG8_SCHED;
            PG8_LDB(B1, 0, 1); PG8_STAGE(PG8_SB(0, 0), b2, voffB);
            PG8_BAR; PG8_WAIT_L(0); PG8_MMA(0, 1, At, B1); PG8_BAR;
            PG8_LDA(At, 0, 1); PG8_STAGE(PG8_SA(0, 0), a2, voffA);
            PG8_BAR; PG8_WAIT_L(0); PG8_MMA(1, 0, At, B0); PG8_BAR; PG8_SCHED;
            PG8_STAGE(PG8_SB(0, 1), b2 + hstep, voffB);
            PG8_WAIT_V(6); PG8_BAR; PG8_MMA(1, 1, At, B1); PG8_BAR;
            PG8_LDB(B0, 1, 0); PG8_SCHED; PG8_LDA(At, 1, 0); PG8_STAGE(PG8_SA(0, 1), a2 + hstep, voffA);
            PG8_WAIT_L(8); PG8_BAR; PG8_WAIT_L(0); PG8_MMA(0, 0, At, B0); PG8_BAR; PG8_SCHED;
            PG8_LDB(B1, 1, 1); PG8_STAGE(PG8_SB(1, 0), b3, voffB);
            PG8_BAR; PG8_WAIT_L(0); PG8_MMA(0, 1, At, B1); PG8_BAR;
            PG8_LDA(At, 1, 1); PG8_STAGE(PG8_SA(1, 0), a3, voffA);
            PG8_BAR; PG8_WAIT_L(0); PG8_MMA(1, 0, At, B0); PG8_BAR; PG8_SCHED;
            PG8_STAGE(PG8_SB(1, 1), b3 + hstep, voffB);
            PG8_WAIT_V(6); PG8_BAR; PG8_MMA(1, 1, At, B1); PG8_BAR;
            }
        }
        if constexpr (ALIGN_EPI) { if (wr == 0) PG8_BAR; }
        if constexpr (!Epi::AFTER_DRAIN) { E(acc, cur, wr, wc, fr, fq); S.done(cur); }
        if (!has_next) break;
#pragma unroll
        for (int a = 0; a < 2; ++a)
#pragma unroll
            for (int b = 0; b < 2; ++b)
#pragma unroll
                for (int m = 0; m < 4; ++m)
#pragma unroll
                    for (int n = 0; n < 2; ++n) acc[a][b][m][n] = (f32x4){0.f, 0.f, 0.f, 0.f};
        cur = nxt; cA = nA; cB = nB; ++ui;
        if constexpr (ALIGN_EPI) { if (wr == 1) PG8_BAR; }
    }
    PG8_WAIT_V(0);
    if constexpr (!ALIGN_EPI) { if (wr == 0) PG8_BAR; }
    PG8_BAR;
    if constexpr (Epi::AFTER_DRAIN) { E.fused(acc, cur, wr, wc, fr, fq, lds, wid, lane); S.done(cur); }
#undef PG8_SA
#undef PG8_SB
#undef PG8_STAGE
#undef PG8_LDA
#undef PG8_LDB
#undef PG8_MMA
#undef PG8_WAIT_V
#undef PG8_WAIT_L
#undef PG8_BAR
#undef PG8_SCHED
}
}

#define DI __device__ __forceinline__
#define LAS __attribute__((address_space(3)))
typedef unsigned short bf16_t;
typedef short bf16x8 __attribute__((ext_vector_type(8)));
typedef short s16x4 __attribute__((ext_vector_type(4)));
typedef float f32x4 __attribute__((ext_vector_type(4)));
typedef float f32x16 __attribute__((ext_vector_type(16)));
typedef unsigned u32x4 __attribute__((ext_vector_type(4)));
typedef unsigned u32x2 __attribute__((ext_vector_type(2)));
typedef float f32x2_t __attribute__((ext_vector_type(2)));
typedef __bf16 bf16x2_t __attribute__((ext_vector_type(2)));
typedef short v4i16_t __attribute__((ext_vector_type(4)));

constexpr int SEQ = 8192, DM = 1024, MROWS = 16384;
constexpr int NWAVES = 8, NTHREADS = 512;
constexpr int LDS_BYTES = 155648;
constexpr float EPS = 1e-6f;
constexpr float LOG2E = 1.4426950408889634f, LN2 = 0.6931471805599453f;
constexpr float NEGB = -1e30f;

constexpr size_t MiB = 1u << 20;
constexpr size_t WS_WA_IN = 0, WS_WB_IN = 40 * MiB, WS_WA_OUT = 56 * MiB, WS_WB_OUT = 60 * MiB;
constexpr size_t WS_XG = 64 * MiB, WS_Z = 96 * MiB, WS_QKV = 128 * MiB;
constexpr size_t WS_SSQ = 272 * MiB, WS_LSE = 273 * MiB, WS_ROPE = 274 * MiB, WS_BAR = 276 * MiB, WS_END = 277 * MiB;

struct Params {
    const float* x; const float* a_norm; const float* a_w_in; const float* a_w_out;
    const float* b_norm; const float* b_w_in; const float* b_lambda; const float* b_subln; const float* b_w_out; const float* final_norm;
    float* out; unsigned char* ws; int ph_lo, ph_hi;
};

DI unsigned cvtpk(float lo, float hi) { f32x2_t v = {lo, hi}; bf16x2_t b = __builtin_convertvector(v, bf16x2_t); return __builtin_bit_cast(unsigned, b); }
DI float bf2f(unsigned short b) { return __uint_as_float(((unsigned)b) << 16); }
DI int crow(int r, int hi) { return (r & 3) + 8 * (r >> 2) + 4 * hi; }
DI s16x4 vtr(const LAS char* p) { return __builtin_bit_cast(s16x4, __builtin_amdgcn_ds_read_tr16_b64_v4i16((LAS v4i16_t*)p)); }
DI float fexp2(float x) { return __builtin_amdgcn_exp2f(x); }
DI float silu(float z) { return z / (1.f + __expf(-z)); }
DI float wave_sum(float v) {
#pragma unroll
    for (int o = 1; o < 64; o <<= 1) v += __shfl_xor(v, o);
    return v;
}
#define MFMA32(a, b, c) __builtin_amdgcn_mfma_f32_32x32x16_bf16((a), (b), (c), 0, 0, 0)

using pg8::Unit;
struct EpiInA {
    static constexpr bool PERM = true, AFTER_DRAIN = false;
    bf16_t* qkv; bf16_t* z; const float* ssq; const float* cs; const float* sn; float qscale;
    DI void operator()(const f32x4 (&acc)[2][2][4][2], const Unit& u, int wr, int wc, int fr, int fq) const {
        const int ct = u.pn; bf16_t* base; int kind;
        if (ct < 36) { const int g = ct / 12, t = (ct % 12) >> 2; kind = t; base = qkv + (size_t)(g * 3 + t) * ((size_t)SEQ * DM) + (ct & 3) * 256; }
        else { kind = 3; base = z + (ct - 36) * 256; }
        const bool rot = (kind < 2) && (wc == 0);
        const float osc = (kind == 0) ? qscale : 1.f;
#pragma unroll
        for (int ai = 0; ai < 2; ++ai)
#pragma unroll
            for (int m = 0; m < 4; ++m) {
                const int row = u.pm * 256 + ai * 128 + wr * 64 + m * 16 + fr;
                const f32x4* sp = (const f32x4*)(ssq + (size_t)row * 16);
                const f32x4 pa = sp[0], pb = sp[1], pc = sp[2], pd = sp[3];
                const float ss = (((pa.x + pa.y) + (pa.z + pa.w)) + ((pb.x + pb.y) + (pb.z + pb.w))) + (((pc.x + pc.y) + (pc.z + pc.w)) + ((pd.x + pd.y) + (pd.z + pd.w)));
                const float rs = 1.0f / sqrtf(ss * (1.0f / DM) + EPS);
                f32x4 c0 = {1.f, 1.f, 1.f, 1.f}, c1 = c0, s0 = {0.f, 0.f, 0.f, 0.f}, s1 = s0;
                if (rot) { const int ib = row * 16 + 8 * (fq & 1); c0 = *(const f32x4*)(cs + ib); c1 = *(const f32x4*)(cs + ib + 4); s0 = *(const f32x4*)(sn + ib); s1 = *(const f32x4*)(sn + ib + 4);
                           if (fq < 2) { s0 = -s0; s1 = -s1; } }
#pragma unroll
                for (int bj = 0; bj < 2; ++bj) {
                    f32x4 v0 = acc[ai][bj][m][0] * rs, v1 = acc[ai][bj][m][1] * rs;
                    if (rot) {
                        f32x4 p0, p1;
#pragma unroll
                        for (int j = 0; j < 4; ++j) { p0[j] = __shfl_xor(v0[j], 32); p1[j] = __shfl_xor(v1[j], 32); }
                        v0 = v0 * c0 + p0 * s0; v1 = v1 * c1 + p1 * s1;
                    }
                    v0 = v0 * osc; v1 = v1 * osc;
                    u32x4 w; w.x = cvtpk(v0[0], v0[1]); w.y = cvtpk(v0[2], v0[3]); w.z = cvtpk(v1[0], v1[1]); w.w = cvtpk(v1[2], v1[3]);
                    *(u32x4*)(base + (size_t)row * DM + bj * 128 + wc * 32 + 8 * fq) = w;
                }
            }
    }
};
struct EpiInB {
    static constexpr bool PERM = true, AFTER_DRAIN = false;
    bf16_t* qkv; bf16_t* z; const float* ssq; const float* cs; const float* sn; float qscale;
    DI void operator()(const f32x4 (&acc)[2][2][4][2], const Unit& u, int wr, int wc, int fr, int fq) const {
        const int ct = u.pn; const int kind = ct >> 2;
        bf16_t* base = (kind < 3 ? qkv + (size_t)kind * ((size_t)MROWS * DM) : z) + (ct & 3) * 256;
        const bool rot = (kind < 2) && ((wc & 1) == 0);
        const float osc = (kind == 0) ? qscale : 1.f;
#pragma unroll
        for (int ai = 0; ai < 2; ++ai)
#pragma unroll
            for (int m = 0; m < 4; ++m) {
                const int row = u.pm * 256 + ai * 128 + wr * 64 + m * 16 + fr;
                const f32x4* sp = (const f32x4*)(ssq + (size_t)row * 16);
                const f32x4 pa = sp[0], pb = sp[1], pc = sp[2], pd = sp[3];
                const float ss = (((pa.x + pa.y) + (pa.z + pa.w)) + ((pb.x + pb.y) + (pb.z + pb.w))) + (((pc.x + pc.y) + (pc.z + pc.w)) + ((pd.x + pd.y) + (pd.z + pd.w)));
                const float rs = 1.0f / sqrtf(ss * (1.0f / DM) + EPS);
                f32x4 c0 = {1.f, 1.f, 1.f, 1.f}, c1 = c0, s0 = {0.f, 0.f, 0.f, 0.f}, s1 = s0;
                if (rot && fq < 2) { const int ib = (row & (SEQ - 1)) * 8; c0 = *(const f32x4*)(cs + ib); c1 = *(const f32x4*)(cs + ib + 4); s0 = *(const f32x4*)(sn + ib); s1 = *(const f32x4*)(sn + ib + 4);
                                     if (fq == 0) { s0 = -s0; s1 = -s1; } }
#pragma unroll
                for (int bj = 0; bj < 2; ++bj) {
                    f32x4 v0 = acc[ai][bj][m][0] * rs, v1 = acc[ai][bj][m][1] * rs;
                    if (rot) {
                        f32x4 p0, p1;
#pragma unroll
                        for (int j = 0; j < 4; ++j) { p0[j] = __shfl_xor(v0[j], 16); p1[j] = __shfl_xor(v1[j], 16); }
                        v0 = v0 * c0 + p0 * s0; v1 = v1 * c1 + p1 * s1;
                    }
                    v0 = v0 * osc; v1 = v1 * osc;
                    u32x4 w; w.x = cvtpk(v0[0], v0[1]); w.y = cvtpk(v0[2], v0[3]); w.z = cvtpk(v1[0], v1[1]); w.w = cvtpk(v1[2], v1[3]);
                    *(u32x4*)(base + (size_t)row * DM + bj * 128 + wc * 32 + 8 * fq) = w;
                }
            }
    }
};
struct EpiOut {
    static constexpr bool PERM = false, AFTER_DRAIN = false;
    const float* xin; float* xout; bf16_t* xg; const float* gnext; float* ssq;
    DI void operator()(const f32x4 (&acc)[2][2][4][2], const Unit& u, int wr, int wc, int fr, int fq) const {
#pragma unroll
        for (int ai = 0; ai < 2; ++ai)
#pragma unroll
            for (int m = 0; m < 4; ++m) {
                const int row = u.pm * 256 + ai * 128 + wr * 64 + m * 16 + fr;
                float ss = 0.f;
#pragma unroll
                for (int bj = 0; bj < 2; ++bj)
#pragma unroll
                    for (int n = 0; n < 2; ++n) {
                        const int col = u.pn * 256 + bj * 128 + wc * 32 + n * 16 + 4 * fq;
                        const size_t off = (size_t)row * DM + col;
                        const f32x4 v = *(const f32x4*)(xin + off) + acc[ai][bj][m][n];
                        *(f32x4*)(xout + off) = v;
                        ss += (v.x * v.x + v.y * v.y) + (v.z * v.z + v.w * v.w);
                        if (gnext) { const f32x4 g4 = *(const f32x4*)(gnext + col); u32x2 w; w.x = cvtpk(v.x * g4.x, v.y * g4.y); w.y = cvtpk(v.z * g4.z, v.w * g4.w); *(u32x2*)(xg + off) = w; }
                    }
                ss += __shfl_xor(ss, 16); ss += __shfl_xor(ss, 32);
                if (fq == 0) ssq[(size_t)row * 16 + u.pn * 4 + wc] = ss;
            }
    }
};

DI unsigned f2bf(float f) { unsigned u = __builtin_bit_cast(unsigned, f); return (u + 0x7fffu + ((u >> 16) & 1u)) >> 16; }
DI unsigned pk2(float lo, float hi) { return f2bf(lo) | (f2bf(hi) << 16); }
DI void transpose_item(const float* W, int K, int N, bf16_t* WT, LAS float* scr, int item, int lane) {
    const int nblk = N / 32, kb = item / nblk, nb = item % nblk, k0 = 64 * kb, n0 = 32 * nb;
#pragma unroll 8
    for (int i = 0; i < 32; ++i) { const int kk = 2 * i + (lane >> 5); scr[kk * 33 + (lane & 31)] = W[(size_t)(k0 + kk) * N + n0 + (lane & 31)]; }
    asm volatile("s_waitcnt lgkmcnt(0)" ::: "memory");
    const int c = lane & 7;
#pragma unroll
    for (int j = 0; j < 4; ++j) { const int n = (lane >> 3) + 8 * j; const LAS float* s = scr + (8 * c) * 33 + n;
        u32x4 o; o.x = pk2(s[0 * 33], s[1 * 33]); o.y = pk2(s[2 * 33], s[3 * 33]); o.z = pk2(s[4 * 33], s[5 * 33]); o.w = pk2(s[6 * 33], s[7 * 33]);
        *(u32x4*)(WT + (size_t)(n0 + n) * K + k0 + 8 * c) = o; }
    asm volatile("s_waitcnt lgkmcnt(0)" ::: "memory");
}

__constant__ float ROPE_INV[16] = {1.0f, 0.44036662578582764f, 0.193922758102417f, 0.08539710193872452f, 0.03760603070259094f, 0.016560440883040428f, 0.00729266507551074f, 0.0032114461064338684f,
                                   0.001414213445968926f, 0.0006227724370546639f, 0.00027424818836152554f, 0.00012076974235242233f, 5.318296462064609e-05f, 2.3419997887685895e-05f, 1.0313385246263351e-05f, 4.541670477919979e-06f};
DI void phase_prologue(const Params& p, LAS unsigned char* lds, int tid, int wid, int lane) {
    unsigned char* ws = p.ws;
    LAS float* scr = (LAS float*)(lds + wid * 16384);
    const int gw = blockIdx.x * NWAVES + wid, NGW = gridDim.x * NWAVES;
    constexpr int I_AIN = 16 * 320, I_OUT = 16 * 32, I_BIN = 16 * 128, PER_J = I_AIN + 2 * I_OUT + I_BIN;
    for (int it = gw; it < 2 * PER_J; it += NGW) {
        const int j = it / PER_J; int r = it % PER_J;
        if (r < I_AIN) { transpose_item(p.a_w_in + (size_t)j * 1024 * 10240, 1024, 10240, (bf16_t*)(ws + WS_WA_IN) + (size_t)j * 10240 * 1024, scr, r, lane); continue; } r -= I_AIN;
        if (r < I_OUT) { transpose_item(p.a_w_out + (size_t)j * 1024 * 1024, 1024, 1024, (bf16_t*)(ws + WS_WA_OUT) + (size_t)j * 1024 * 1024, scr, r, lane); continue; } r -= I_OUT;
        if (r < I_BIN) { transpose_item(p.b_w_in + (size_t)j * 1024 * 4096, 1024, 4096, (bf16_t*)(ws + WS_WB_IN) + (size_t)j * 4096 * 1024, scr, r, lane); continue; } r -= I_BIN;
        transpose_item(p.b_w_out + (size_t)j * 1024 * 1024, 1024, 1024, (bf16_t*)(ws + WS_WB_OUT) + (size_t)j * 1024 * 1024, scr, r, lane);
    }
    bf16_t* xg = (bf16_t*)(ws + WS_XG); float* ssq = (float*)(ws + WS_SSQ);
    for (int m = gw; m < MROWS; m += NGW) {
        const f32x4* xr = (const f32x4*)(p.x + (size_t)m * DM) + lane; const f32x4* gr = (const f32x4*)p.a_norm + lane;
        float s = 0.f;
#pragma unroll
        for (int j = 0; j < 4; ++j) { const f32x4 v = xr[64 * j], g = gr[64 * j]; s += (v.x * v.x + v.y * v.y) + (v.z * v.z + v.w * v.w);
            u32x2 w; w.x = cvtpk(v.x * g.x, v.y * g.y); w.y = cvtpk(v.z * g.z, v.w * g.w); *((u32x2*)(xg + (size_t)m * DM) + lane + 64 * j) = w; }
        s = wave_sum(s);
        if (lane < 16) ssq[(size_t)m * 16 + lane] = (lane == 0) ? s : 0.f;
    }
    float* cosA = (float*)(ws + WS_ROPE); float* sinA = cosA + SEQ * 16; float* cosB = sinA + SEQ * 16; float* sinB = cosB + SEQ * 8;
    for (int idx = blockIdx.x * NTHREADS + tid; idx < SEQ * 24; idx += gridDim.x * NTHREADS) {
        int pos, i, rotd; float* cd; float* sd;
        if (idx < SEQ * 16) { pos = idx >> 4; i = idx & 15; rotd = 32; cd = cosA + idx; sd = sinA + idx; }
        else { const int k = idx - SEQ * 16; pos = k >> 3; i = k & 7; rotd = 16; cd = cosB + k; sd = sinB + k; }
        const float inv = ROPE_INV[(rotd == 32) ? i : 2 * i];
        const float ang = (float)pos * inv;
        const double rev = (double)ang * 0.15915494309189535;
        const double fr = rev - rint(rev);
        *cd = __builtin_amdgcn_cosf((float)fr); *sd = __builtin_amdgcn_sinf((float)fr);
    }
}

constexpr int AW_K = 0, AW_V = 8704, AW_BYTES = 18944;
DI void attnA_item(LAS char* wl, bf16_t* Qb, const bf16_t* Kb, const bf16_t* Vb, float* lse, int r, int rho, int c, int h, int lane, bool dry) {
    const int q = lane & 31, hh = lane >> 5, lr = lane >> 4, lc = lane & 15;
    const int tq = rho + r * (32 * c + q);
    bf16_t* Qrow = Qb + (size_t)tq * DM + h * 128;
    bf16x8 qf[8];
#pragma unroll
    for (int st = 0; st < 8; ++st) qf[st] = *(const bf16x8*)(Qrow + 16 * st + 8 * hh);
    f32x16 o[4];
#pragma unroll
    for (int db = 0; db < 4; ++db)
#pragma unroll
        for (int i = 0; i < 16; ++i) o[db][i] = 0.f;
    float m_run = NEGB, l_run = 0.f;
    const int t_lo = (c - 4 > 0) ? c - 4 : 0;
    u32x4 kreg[8], vreg[8];
    {
        const size_t tok0 = (size_t)(rho + r * (32 * t_lo + lr));
#pragma unroll
        for (int it = 0; it < 8; ++it) { const size_t off = (tok0 + (size_t)r * 4 * it) * DM + h * 128 + lc * 8; kreg[it] = *(const u32x4*)(Kb + off); vreg[it] = *(const u32x4*)(Vb + off); }
    }
    const LAS char* vb = wl + AW_V + (4 * hh + (lc >> 2)) * 320 + (lr & 1) * 32 + (lane & 3) * 8;
    for (int t = t_lo; t <= c; ++t) {
#pragma unroll
        for (int it = 0; it < 8; ++it) { *(LAS u32x4*)(wl + AW_K + (4 * it + lr) * 272 + lc * 16) = kreg[it]; *(LAS u32x4*)(wl + AW_V + (4 * it + lr) * 320 + lc * 16) = vreg[it]; }
        if (t < c) {
            const size_t tok0 = (size_t)(rho + r * (32 * (t + 1) + lr));
#pragma unroll
            for (int it = 0; it < 8; ++it) { const size_t off = (tok0 + (size_t)r * 4 * it) * DM + h * 128 + lc * 8; kreg[it] = *(const u32x4*)(Kb + off); vreg[it] = *(const u32x4*)(Vb + off); }
        }
        f32x16 s;
#pragma unroll
        for (int i = 0; i < 16; ++i) s[i] = 0.f;
#pragma unroll
        for (int st = 0; st < 8; ++st) { const bf16x8 a = *(const LAS bf16x8*)(wl + AW_K + q * 272 + st * 32 + hh * 16); s = MFMA32(a, qf[st], s); }
        if (t == c) {
#pragma unroll
            for (int i = 0; i < 16; ++i) if (crow(i, hh) > q) s[i] = NEGB;
        }
        if (t == c - 4) {
#pragma unroll
            for (int i = 0; i < 16; ++i) if (crow(i, hh) < q) s[i] = NEGB;
        }
        float mx = s[0];
#pragma unroll
        for (int i = 1; i < 16; ++i) mx = fmaxf(mx, s[i]);
        mx = fmaxf(mx, __shfl_xor(mx, 32));
        const float m_new = fmaxf(m_run, mx);
        const float alpha = fexp2(m_run - m_new);
        m_run = m_new;
        float ps = 0.f;
#pragma unroll
        for (int i = 0; i < 16; ++i) { s[i] = fexp2(s[i] - m_new); ps += s[i]; }
        l_run = l_run * alpha + ps;
#pragma unroll
        for (int db = 0; db < 4; ++db)
#pragma unroll
            for (int i = 0; i < 16; ++i) o[db][i] *= alpha;
        bf16x8 pf[2];
#pragma unroll
        for (int s2 = 0; s2 < 2; ++s2) { u32x4 w; w.x = cvtpk(s[8 * s2], s[8 * s2 + 1]); w.y = cvtpk(s[8 * s2 + 2], s[8 * s2 + 3]); w.z = cvtpk(s[8 * s2 + 4], s[8 * s2 + 5]); w.w = cvtpk(s[8 * s2 + 6], s[8 * s2 + 7]); pf[s2] = __builtin_bit_cast(bf16x8, w); }
#pragma unroll
        for (int db = 0; db < 4; ++db)
#pragma unroll
            for (int s2 = 0; s2 < 2; ++s2) {
                const s16x4 lo = vtr(vb + (16 * s2) * 320 + db * 64), hi = vtr(vb + (16 * s2 + 8) * 320 + db * 64);
                const bf16x8 a = (bf16x8){lo[0], lo[1], lo[2], lo[3], hi[0], hi[1], hi[2], hi[3]};
                o[db] = MFMA32(a, pf[s2], o[db]);
            }
    }
    const float l_tot = l_run + __shfl_xor(l_run, 32);
    const float inv = 1.0f / l_tot;
    if (dry) return;
#pragma unroll
    for (int db = 0; db < 4; ++db)
#pragma unroll
        for (int i4 = 0; i4 < 4; ++i4) {
            u32x2 w; w.x = cvtpk(o[db][4 * i4] * inv, o[db][4 * i4 + 1] * inv); w.y = cvtpk(o[db][4 * i4 + 2] * inv, o[db][4 * i4 + 3] * inv);
            *(u32x2*)(Qrow + 32 * db + 8 * i4 + 4 * hh) = w;
        }
    if (hh == 0) lse[(size_t)tq * 8 + h] = (m_run + __log2f(l_tot)) * LN2;
}

DI void phase_attnA(const Params& p, LAS unsigned char* lds, int wid, int lane, bool dry) {
    bf16_t* qkv = (bf16_t*)(p.ws + WS_QKV); float* lse = (float*)(p.ws + WS_LSE);
    LAS char* wl = (LAS char*)lds + wid * AW_BYTES;
    const int gw = blockIdx.x * NWAVES + wid, NGW = gridDim.x * NWAVES;
    for (int id = gw; id < 3 * 2048; id += NGW) {
        const int g = id >> 11, rem = id & 2047, h = rem >> 8, cc = rem & 255;
        const int r = (g == 0) ? 1 : (g == 1) ? 4 : 16;
        const int cpr = 256 / r;
        const int rho = cc / cpr, c = cc % cpr;
        bf16_t* Qb = qkv + (size_t)(g * 3 + 0) * ((size_t)SEQ * DM);
        const bf16_t* Kb = qkv + (size_t)(g * 3 + 1) * ((size_t)SEQ * DM);
        const bf16_t* Vb = qkv + (size_t)(g * 3 + 2) * ((size_t)SEQ * DM);
        attnA_item(wl, Qb, Kb, Vb, lse + (size_t)g * SEQ * 8, r, rho, c, h, lane, dry);
    }
}

DI void phase_combineA(const Params& p, int bidx, int tid) {
    const bf16_t* qkv = (const bf16_t*)(p.ws + WS_QKV); const float* lse = (const float*)(p.ws + WS_LSE);
    bf16_t* zb = (bf16_t*)(p.ws + WS_Z) + (size_t)bidx * SEQ * DM;
    for (int idx = blockIdx.x * NTHREADS + tid; idx < SEQ * 128; idx += gridDim.x * NTHREADS) {
        const int row = idx >> 7, ch = idx & 127, head = ch >> 4;
        const float l0 = lse[(size_t)row * 8 + head], l1 = lse[(size_t)(SEQ + row) * 8 + head], l2 = lse[(size_t)(2 * SEQ + row) * 8 + head];
        const float mx = fmaxf(l0, fmaxf(l1, l2));
        float e0 = __expf(l0 - mx), e1 = __expf(l1 - mx), e2 = __expf(l2 - mx);
        const float inv = 1.0f / (e0 + e1 + e2); e0 *= inv; e1 *= inv; e2 *= inv;
        const size_t off = (size_t)row * DM + ch * 8;
        const u32x4 a0 = *(const u32x4*)(qkv + off), a1 = *(const u32x4*)(qkv + (size_t)3 * SEQ * DM + off), a2 = *(const u32x4*)(qkv + (size_t)6 * SEQ * DM + off);
        const u32x4 zz = *(const u32x4*)(zb + off);
        u32x4 w;
#pragma unroll
        for (int k = 0; k < 4; ++k) {
            const float o_lo = e0 * __uint_as_float(a0[k] << 16) + e1 * __uint_as_float(a1[k] << 16) + e2 * __uint_as_float(a2[k] << 16);
            const float o_hi = e0 * __uint_as_float(a0[k] & 0xffff0000u) + e1 * __uint_as_float(a1[k] & 0xffff0000u) + e2 * __uint_as_float(a2[k] & 0xffff0000u);
            const float z_lo = __uint_as_float(zz[k] << 16), z_hi = __uint_as_float(zz[k] & 0xffff0000u);
            w[k] = cvtpk(o_lo * silu(z_lo), o_hi * silu(z_hi));
        }
        *(u32x4*)(zb + off) = w;
    }
}

constexpr int BB_BUF = 37888, BB_V = 17408, BB_EX = 75776;
constexpr float BB_THR = 8.0f;
#define SBAR() __builtin_amdgcn_sched_barrier(0)
DI void attnB_unit(LAS char* lds, const bf16_t* Q, const bf16_t* K, const bf16_t* V, bf16_t* Z, const float* subln, int b, int h, int qb, float lam, float oscale, int tid, int wid, int lane, bool dry) {
    const int strm = wid >> 2, wq = wid & 3, q = lane & 31, hh = lane >> 5;
    const int q0 = qb * 128 + wq * 32;
    const size_t rowbase = (size_t)b * SEQ;
    const char* Qb = (const char*)(Q + (rowbase + q0) * DM + h * 128 + strm * 64);
    unsigned qoff = (unsigned)(q * DM + 8 * hh) * 2u; asm volatile("" : "+v"(qoff));
    bf16x8 qf[4];
#pragma unroll
    for (int st = 0; st < 4; ++st) qf[st] = *(const bf16x8*)(Qb + 32 * st + qoff);
    f32x16 o[4];
    const f32x16 zero16 = {0.f, 0.f, 0.f, 0.f, 0.f, 0.f, 0.f, 0.f, 0.f, 0.f, 0.f, 0.f, 0.f, 0.f, 0.f, 0.f};
#pragma unroll
    for (int db = 0; db < 4; ++db)
#pragma unroll
        for (int i = 0; i < 16; ++i) o[db][i] = 0.f;
    float mhat = 0.f, l_run = 0.f;
    const int NT = 2 * qb + 2, NTw = (q0 >> 6) + 1;
    const char* Kg = (const char*)(K + rowbase * DM + h * 128); const char* Vg = (const char*)(V + rowbase * DM + h * 128);
    const int lrow = tid >> 4, lcc = tid & 15;
    unsigned goff = (unsigned)(lrow * DM + lcc * 8) * 2u; asm volatile("" : "+v"(goff));
    const int kq = q * 272 + strm * 128 + hh * 16;
    const int vq = BB_V + (4 * hh + ((lane & 15) >> 2)) * 320 + ((lane >> 4) & 1) * 32 + (lane & 3) * 8;
    u32x4 kr[2], vr[2];
#define BB_GLOADK(t) do { const char* b_ = Kg + (size_t)(t) * (64 * DM * 2); kr[0] = *(const u32x4*)(b_ + goff); kr[1] = *(const u32x4*)(b_ + 32 * DM * 2 + goff); } while (0)
#define BB_GLOADV(t) do { const char* b_ = Vg + (size_t)(t) * (64 * DM * 2); vr[0] = *(const u32x4*)(b_ + goff); vr[1] = *(const u32x4*)(b_ + 32 * DM * 2 + goff); } while (0)
#define BB_LSTOREK(buf) do { _Pragma("unroll") for (int i_ = 0; i_ < 2; ++i_) *(LAS u32x4*)(lds + (buf) * BB_BUF + (lrow + 32 * i_) * 272 + lcc * 16) = kr[i_]; } while (0)
#define BB_LSTOREV(buf) do { _Pragma("unroll") for (int i_ = 0; i_ < 2; ++i_) *(LAS u32x4*)(lds + (buf) * BB_BUF + BB_V + (lrow + 32 * i_) * 320 + lcc * 16) = vr[i_]; } while (0)
#define BB_MASK(P0, P1, t) do { int qh_ = q0 + q - 64 * (t) - 4 * hh; asm volatile("" : "+v"(qh_));   \
        _Pragma("unroll") for (int i = 0; i < 16; ++i) { const int c_ = (i & 3) + 8 * (i >> 2); if (c_ > qh_) P0[i] = NEGB; if (c_ + 32 > qh_) P1[i] = NEGB; } } while (0)
#define BB_ROWMAX(P0, P1, rm) do { float a_ = fmaxf(fmaxf(P0[0], P0[1]), P1[0]), b_ = fmaxf(fmaxf(P0[2], P0[3]), P1[1]); a_ = fmaxf(fmaxf(a_, P1[2]), P1[3]); \
        _Pragma("unroll") for (int r = 4; r < 16; r += 4) { a_ = fmaxf(fmaxf(a_, P0[r]), P0[r + 1]); b_ = fmaxf(fmaxf(b_, P0[r + 2]), P0[r + 3]); a_ = fmaxf(fmaxf(a_, P1[r]), P1[r + 1]); b_ = fmaxf(fmaxf(b_, P1[r + 2]), P1[r + 3]); } \
        rm = fmaxf(a_, b_); rm = fmaxf(rm, __shfl_xor(rm, 32)); } while (0)
#define BB_EXP4(P, B) do { P[B] = fexp2(P[B] - mhat); P[B + 1] = fexp2(P[B + 1] - mhat); P[B + 2] = fexp2(P[B + 2] - mhat); P[B + 3] = fexp2(P[B + 3] - mhat); } while (0)
#define BB_PACK(P, B) (u32x4){cvtpk(P[B], P[B + 1]), cvtpk(P[B + 2], P[B + 3]), cvtpk(P[B + 4], P[B + 5]), cvtpk(P[B + 6], P[B + 7])}
#define BB_VRD(L, H, S2, DB) do { L = vtr(vb_ + (16 * (S2)) * 320 + (DB) * 64); H = vtr(vb_ + (16 * (S2) + 8) * 320 + (DB) * 64); } while (0)
#define BB_PVM(PF, DB, L, H, A0, A1) do { o[DB] = MFMA32(((bf16x8){L[0], L[1], L[2], L[3], H[0], H[1], H[2], H[3]}), __builtin_bit_cast(bf16x8, PF), o[DB]); sacc_ += (A0) + (A1); SBAR(); } while (0)
#define BB_PVALL(C0, C1) do { s16x4 la_, ha_, lb_, hb_, lc_, hc_; u32x4 pf_; \
        BB_VRD(la_, ha_, 0, 0); BB_VRD(lb_, hb_, 0, 1); \
        pf_ = BB_PACK(C0, 0); BB_VRD(lc_, hc_, 0, 2); BB_PVM(pf_, 0, la_, ha_, C0[0], C0[1]); \
        BB_VRD(la_, ha_, 0, 3); BB_PVM(pf_, 1, lb_, hb_, C0[2], C0[3]); \
        BB_VRD(lb_, hb_, 1, 0); BB_PVM(pf_, 2, lc_, hc_, C0[4], C0[5]); \
        BB_VRD(lc_, hc_, 1, 1); BB_PVM(pf_, 3, la_, ha_, C0[6], C0[7]); \
        pf_ = BB_PACK(C0, 8); BB_VRD(la_, ha_, 1, 2); BB_PVM(pf_, 0, lb_, hb_, C0[8], C0[9]); \
        BB_VRD(lb_, hb_, 1, 3); BB_PVM(pf_, 1, lc_, hc_, C0[10], C0[11]); \
        BB_VRD(lc_, hc_, 2, 0); BB_PVM(pf_, 2, la_, ha_, C0[12], C0[13]); \
        BB_VRD(la_, ha_, 2, 1); BB_PVM(pf_, 3, lb_, hb_, C0[14], C0[15]); \
        pf_ = BB_PACK(C1, 0); BB_VRD(lb_, hb_, 2, 2); BB_PVM(pf_, 0, lc_, hc_, C1[0], C1[1]); \
        BB_VRD(lc_, hc_, 2, 3); BB_PVM(pf_, 1, la_, ha_, C1[2], C1[3]); \
        BB_VRD(la_, ha_, 3, 0); BB_PVM(pf_, 2, lb_, hb_, C1[4], C1[5]); \
        BB_VRD(lb_, hb_, 3, 1); BB_PVM(pf_, 3, lc_, hc_, C1[6], C1[7]); \
        pf_ = BB_PACK(C1, 8); BB_VRD(lc_, hc_, 3, 2); BB_PVM(pf_, 0, la_, ha_, C1[8], C1[9]); \
        BB_VRD(la_, ha_, 3, 3); BB_PVM(pf_, 1, lb_, hb_, C1[10], C1[11]); \
        BB_PVM(pf_, 2, lc_, hc_, C1[12], C1[13]); \
        BB_PVM(pf_, 3, la_, ha_, C1[14], C1[15]); \
    } while (0)
#define BB_STEP(C0, C1, N0, N1, T) do { \
        const int t_ = (T); const int buf_ = t_ & 1; \
        if (t_ + 2 < NT) BB_GLOADK(t_ + 2); \
        if (t_ < NTw) { \
            if (t_ > 0) { \
                if (t_ == NTw - 1) BB_MASK(C0, C1, t_); \
                float rm_; BB_ROWMAX(C0, C1, rm_); \
                rm_ -= mhat; \
                if (__any(rm_ > BB_THR)) { const float dl_ = fmaxf(rm_, 0.f); mhat += dl_; \
                    const float f_ = fexp2(-dl_); l_run *= f_; \
                    _Pragma("unroll") for (int db = 0; db < 4; ++db) _Pragma("unroll") for (int i = 0; i < 16; ++i) o[db][i] *= f_; } \
            } \
            if (t_ + 1 < NTw) { \
                const LAS char* kb_ = lds + (buf_ ^ 1) * BB_BUF + kq; \
                bf16x8 fa_ = *(const LAS bf16x8*)(kb_), fb_ = *(const LAS bf16x8*)(kb_ + 32 * 272), fc_ = *(const LAS bf16x8*)(kb_ + 32); \
                SBAR(); \
                N0 = MFMA32(fa_, qf[0], zero16); BB_EXP4(C0, 0);  fa_ = *(const LAS bf16x8*)(kb_ + 32 * 272 + 32); SBAR(); \
                N1 = MFMA32(fb_, qf[0], zero16); BB_EXP4(C0, 4);  fb_ = *(const LAS bf16x8*)(kb_ + 64); SBAR(); \
                N0 = MFMA32(fc_, qf[1], N0);   BB_EXP4(C0, 8);  fc_ = *(const LAS bf16x8*)(kb_ + 32 * 272 + 64); SBAR(); \
                N1 = MFMA32(fa_, qf[1], N1);   BB_EXP4(C0, 12); fa_ = *(const LAS bf16x8*)(kb_ + 96); SBAR(); \
                N0 = MFMA32(fb_, qf[2], N0);   BB_EXP4(C1, 0);  fb_ = *(const LAS bf16x8*)(kb_ + 32 * 272 + 96); SBAR(); \
                N1 = MFMA32(fc_, qf[2], N1);   BB_EXP4(C1, 4);  SBAR(); \
                N0 = MFMA32(fa_, qf[3], N0);   BB_EXP4(C1, 8);  SBAR(); \
                N1 = MFMA32(fb_, qf[3], N1);   BB_EXP4(C1, 12); SBAR(); \
            } else { \
                _Pragma("unroll") for (int i = 0; i < 16; ++i) { C0[i] = fexp2(C0[i] - mhat); C1[i] = fexp2(C1[i] - mhat); } \
            } \
        } \
        if (t_ + 2 < NT) BB_LSTOREK(buf_); \
        if (t_ + 1 < NT) BB_GLOADV(t_ + 1); \
        SBAR(); \
        if (t_ < NTw) { \
            const LAS char* vb_ = lds + buf_ * BB_BUF + vq; float sacc_ = 0.f; \
            BB_PVALL(C0, C1); \
            l_run += sacc_; \
        } \
        if (t_ + 1 < NT) BB_LSTOREV(buf_ ^ 1); \
        __syncthreads(); \
    } while (0)
    BB_GLOADK(0); BB_LSTOREK(0); BB_GLOADV(0); BB_LSTOREV(0); BB_GLOADK(1); BB_LSTOREK(1);
    __syncthreads();
    f32x16 pA0, pA1, pB0, pB1;
    {
        const LAS char* kb_ = lds + kq;
#pragma unroll
        for (int i = 0; i < 16; ++i) { pA0[i] = 0.f; pA1[i] = 0.f; pB0[i] = 0.f; pB1[i] = 0.f; }
#pragma unroll
        for (int st = 0; st < 4; ++st) { const bf16x8 a0 = *(const LAS bf16x8*)(kb_ + st * 32), a1 = *(const LAS bf16x8*)(kb_ + 32 * 272 + st * 32); pA0 = MFMA32(a0, qf[st], pA0); pA1 = MFMA32(a1, qf[st], pA1); }
        if (NTw == 1) BB_MASK(pA0, pA1, 0);
        float rm; BB_ROWMAX(pA0, pA1, rm);
        mhat = rm;
    }
#pragma unroll 1
    for (int t = 0; t < NT; t += 2) {
        BB_STEP(pA0, pA1, pB0, pB1, t);
        BB_STEP(pB0, pB1, pA0, pA1, t + 1);
    }
#undef BB_GLOADK
#undef BB_GLOADV
#undef BB_LSTOREK
#undef BB_LSTOREV
#undef BB_MASK
#undef BB_ROWMAX
#undef BB_EXP4
#undef BB_PACK
#undef BB_VRD
#undef BB_PVM
#undef BB_PVALL
#undef BB_STEP
    const float l_tot = l_run + __shfl_xor(l_run, 32);
    const float inv = 1.0f / l_tot;
    LAS float* ex = (LAS float*)(lds + BB_EX) + wq * 4096;
    if (strm == 1) {
#pragma unroll
        for (int db = 0; db < 4; ++db)
#pragma unroll
            for (int i = 0; i < 16; ++i) ex[(db * 16 + i) * 64 + lane] = o[db][i] * inv;
    }
    __syncthreads();
    if (strm == 0) {
        float ss = 0.f;
#pragma unroll
        for (int db = 0; db < 4; ++db) {
#pragma unroll
            for (int i = 0; i < 16; ++i) { const float d = o[db][i] * inv - lam * ex[(db * 16 + i) * 64 + lane]; o[db][i] = d; ss += d * d; }
            __builtin_amdgcn_sched_barrier(0); }
        ss += __shfl_xor(ss, 32);
        const float rn = (1.0f / sqrtf(ss * (1.0f / 128.0f) + EPS)) * oscale;
        char* Zb = (char*)(Z + (rowbase + q0) * DM + h * 128);
        asm volatile("" : "+s"(subln));
        unsigned zoff = (unsigned)(q * DM + 4 * hh) * 2u; asm volatile("" : "+v"(zoff));
#pragma unroll
        for (int db = 0; db < 4; ++db)
#pragma unroll
            for (int i4 = 0; i4 < 4; ++i4) {
                const int d0 = 32 * db + 8 * i4 + 4 * hh;
                const u32x2 zz = *(const u32x2*)(Zb + (32 * db + 8 * i4) * 2 + zoff);
                const f32x4 sl = *(const f32x4*)(subln + d0);
                const float z0 = __uint_as_float(zz.x << 16), z1 = __uint_as_float(zz.x & 0xffff0000u), z2 = __uint_as_float(zz.y << 16), z3 = __uint_as_float(zz.y & 0xffff0000u);
                u32x2 w; w.x = cvtpk(o[db][4 * i4] * rn * sl.x * silu(z0), o[db][4 * i4 + 1] * rn * sl.y * silu(z1));
                w.y = cvtpk(o[db][4 * i4 + 2] * rn * sl.z * silu(z2), o[db][4 * i4 + 3] * rn * sl.w * silu(z3));
                if (!dry) *(u32x2*)(Zb + (32 * db + 8 * i4) * 2 + zoff) = w;
                __builtin_amdgcn_sched_barrier(0);
            }
    }
}

DI void phase_attnB(const Params& p, LAS unsigned char* lds, int j, int layer, int tid, int wid, int lane, bool dry) {
    const bf16_t* Q = (const bf16_t*)(p.ws + WS_QKV); const bf16_t* K = Q + (size_t)MROWS * DM; const bf16_t* V = K + (size_t)MROWS * DM;
    bf16_t* Z = (bf16_t*)(p.ws + WS_Z);
    const float* lp = p.b_lambda + j * 256;
    const float d1 = wave_sum(lp[lane] * lp[64 + lane]), d2 = wave_sum(lp[128 + lane] * lp[192 + lane]);
    asm volatile("" : "+s"(layer));
    const float lam_init = (layer == 1) ? 0.35550906759096926f : 0.5560582041556006f;
    const float lam = expf(d1) - expf(d2) + lam_init;
    const float oscale = 1.0f - lam_init;
    const float* subln = p.b_subln + j * 128;
    for (int v = blockIdx.x; v < 256; v += gridDim.x) {
        const int bh = v >> 4, s = v & 15;
#pragma unroll 1
        for (int k = 0; k < 4; ++k) {
            const int qb = (k == 0) ? 63 - s : (k == 1) ? 32 + s : (k == 2) ? 31 - s : s;
            attnB_unit((LAS char*)lds, Q, K, V, Z, subln, bh >> 3, bh & 7, qb, lam, oscale, tid, wid, lane, dry);
        }
    }
}

DI void phase_final(const Params& p, int wid, int lane) {
    const int gw = blockIdx.x * NWAVES + wid, NGW = gridDim.x * NWAVES;
    for (int m = gw; m < MROWS; m += NGW) {
        f32x4* xr = (f32x4*)(p.out + (size_t)m * DM) + lane; const f32x4* gr = (const f32x4*)p.final_norm + lane;
        f32x4 v[4]; float s = 0.f;
#pragma unroll
        for (int j = 0; j < 4; ++j) { v[j] = xr[64 * j]; s += (v[j].x * v[j].x + v[j].y * v[j].y) + (v[j].z * v[j].z + v[j].w * v[j].w); }
        const float rs = 1.0f / sqrtf(wave_sum(s) * (1.0f / DM) + EPS);
#pragma unroll
        for (int j = 0; j < 4; ++j) xr[64 * j] = v[j] * rs * gr[64 * j];
    }
}

#define XB_TMO      128
#define XB_XCNT(j)  (256  + 64 * (j))
#define XB_XSUB(j)  (1280 + 64 * (j))
#define XB_XGEN(j)  (2304 + 64 * (j))
#define XB_TOP      3328
#define XB_TOPGEN   3392
#define XCD_BAR_WORDS 3456
#define XB_SPIN_CAP (1u << 18)

__device__ __forceinline__ unsigned xb_ld(unsigned* p)              { return __hip_atomic_load(p, __ATOMIC_RELAXED, __HIP_MEMORY_SCOPE_AGENT); }
__device__ __forceinline__ unsigned xb_add(unsigned* p, unsigned v) { return __hip_atomic_fetch_add(p, v, __ATOMIC_RELAXED, __HIP_MEMORY_SCOPE_AGENT); }
__device__ __forceinline__ unsigned xb_xcc_id() { return (unsigned)__builtin_amdgcn_s_getreg((3 << 11) | 20) & 0xFu; }
#define XB_SPIN(cond, bar) do { unsigned _sp = 0; while (cond) { __builtin_amdgcn_s_sleep(1); \
    if ((++_sp & 255u) == 0u) { if (xb_ld(&(bar)[XB_TMO])) break; if (_sp > XB_SPIN_CAP) { atomicAdd(&(bar)[XB_TMO], 1u); break; } } } } while (0)

struct XcdBarrier {
    unsigned* bar; unsigned x;
    volatile LAS unsigned* st;
};

__device__ __forceinline__ XcdBarrier xcd_barrier_post(unsigned* bar, volatile LAS unsigned* st) {
    XcdBarrier b; b.bar = bar; b.x = xb_xcc_id(); b.st = st;
    if (threadIdx.x == 0) (void)xb_add(&bar[XB_XCNT(b.x)], 1u);
    return b;
}
__device__ __forceinline__ void xcd_barrier_complete(unsigned* bar, unsigned x, unsigned& nloc, unsigned& nx) {
    const unsigned G = gridDim.x * gridDim.y * gridDim.z;
    unsigned sum, cnt, mine, sp = 0u;
    for (;;) {
        sum = 0u; cnt = 0u; mine = 0u;
#pragma unroll
        for (unsigned j = 0; j < 16; ++j) { const unsigned c = xb_ld(&bar[XB_XCNT(j)]); sum += c; cnt += (c > 0u) ? 1u : 0u; mine = (j == x) ? c : mine; }
        if (sum == G) break;
        __builtin_amdgcn_s_sleep(1);
        if ((++sp & 255u) == 0u) { if (xb_ld(&bar[XB_TMO])) break; if (sp > XB_SPIN_CAP) { atomicAdd(&bar[XB_TMO], 1u); break; } }
    }
    nloc = mine > 0u ? mine : 1u; nx = cnt > 0u ? cnt : 1u;
}

__device__ __forceinline__ void xcd_barrier(const XcdBarrier& b) {
    asm volatile("s_waitcnt vmcnt(0)" ::: "memory");
    __syncthreads();
    if (threadIdx.x == 0) {
        unsigned* bar = b.bar;
        __builtin_amdgcn_s_waitcnt(0);
        unsigned nloc = b.st[0], nx = b.st[1];
        if (nloc == 0u) { xcd_barrier_complete(bar, b.x, nloc, nx); b.st[0] = nloc; b.st[1] = nx; }
        const unsigned old = xb_add(&bar[XB_XSUB(b.x)], 1u);
        const unsigned gen = old / nloc;
        if (old + 1u == (gen + 1u) * nloc) {
            __builtin_amdgcn_fence(__ATOMIC_RELEASE, "agent");
            asm volatile("s_waitcnt vmcnt(0)" ::: "memory");
            const unsigned og = xb_add(&bar[XB_TOP], 1u);
            const unsigned tg = og / nx;
            if (og + 1u == (tg + 1u) * nx) xb_add(&bar[XB_TOPGEN], 1u);
            else XB_SPIN(xb_ld(&bar[XB_TOPGEN]) == tg, bar);
            __builtin_amdgcn_fence(__ATOMIC_ACQUIRE, "agent");
            xb_add(&bar[XB_XGEN(b.x)], 1u);
            asm volatile("s_waitcnt vmcnt(0)" ::: "memory");
        } else {
            XB_SPIN(xb_ld(&bar[XB_XGEN(b.x)]) == gen, bar);
            __builtin_amdgcn_fence(__ATOMIC_ACQUIRE, "agent");
            asm volatile("s_waitcnt vmcnt(0)" ::: "memory");
        }
    }
    __syncthreads();
}

#ifndef PROBE_KIND
#define PROBE_KIND -1
#endif
__global__ void __launch_bounds__(NTHREADS, 2) fwd_megakernel(Params p_arg) {
    extern __shared__ __attribute__((aligned(16))) unsigned char lds_raw[];
    LAS unsigned char* lds = (LAS unsigned char*)lds_raw;
    cg::grid_group grid = cg::this_grid();
    const int lo = p_arg.ph_lo, hi = p_arg.ph_hi;
    volatile LAS unsigned* bst = (volatile LAS unsigned*)(lds + LDS_BYTES - 64);
    unsigned* barw = (unsigned*)(p_arg.ws + WS_BAR);
    if (threadIdx.x == 0) { bst[0] = 0u; bst[1] = 0u; }
    if (blockIdx.x == 0) for (int i = threadIdx.x; i < XCD_BAR_WORDS; i += NTHREADS) barw[i] = 0u;
    __syncthreads();
    XcdBarrier xb; xb.bar = barw; xb.x = 0; xb.st = bst;
#pragma unroll 1
    for (int ph = lo; ph < hi; ++ph) {
        int kind;
        if (ph == 0) kind = 0; else if (ph == 21) kind = 7; else { const int r_ = (ph - 1) % 10; kind = (r_ < 6) ? 1 + r_ % 3 : (r_ == 7) ? 4 : (r_ == 8) ? 5 : 6; }
        const int reps = (kind == PROBE_KIND) ? 2 : 1;
#pragma unroll 1
        for (int rep = 0; rep < reps; ++rep) {
        int tid = threadIdx.x; asm volatile("" : "+v"(tid));
#if defined(__HIP_DEVICE_COMPILE__)
        const __attribute__((address_space(4))) Params* pp = (const __attribute__((address_space(4))) Params*)__builtin_amdgcn_kernarg_segment_ptr();
        asm volatile("" : "+s"(pp));
        const Params p = *pp;
#else
        const Params p = p_arg;
#endif
        const int lane = tid & 63, wid = __builtin_amdgcn_readfirstlane(tid >> 6);
        unsigned char* ws = p.ws;
        bf16_t* XG = (bf16_t*)(ws + WS_XG); bf16_t* Zb = (bf16_t*)(ws + WS_Z); bf16_t* QKV = (bf16_t*)(ws + WS_QKV);
        float* SSQ = (float*)(ws + WS_SSQ);
        const float* cosA = (const float*)(ws + WS_ROPE); const float* sinA = cosA + SEQ * 16; const float* cosB = sinA + SEQ * 16; const float* sinB = cosB + SEQ * 8;
        const bool dry = (PROBE_KIND >= 0) && (rep + 1 < reps) && (p.ph_hi < 1000);
        if (ph == 0) phase_prologue(p, lds, tid, wid, lane);
        else if (ph == 21) phase_final(p, wid, lane);
        else {
            const int k = ph - 1, pair = k / 10, r = k % 10;
            if (r < 6) {
                const int bidx = r / 3, s = r % 3;
                if (s == 0) {
                    pg8::Gemm g{XG + (size_t)bidx * SEQ * DM, (const bf16_t*)(ws + WS_WA_IN) + (size_t)pair * 10240 * 1024, SEQ, 10240, DM};
                    pg8::StaticOrder S; S.init(SEQ, 10240, gridDim.x, blockIdx.x);
                    EpiInA E{QKV, Zb + (size_t)bidx * SEQ * DM, SSQ + (size_t)bidx * SEQ * 16, cosA, sinA, 0.08838834764831845f * LOG2E};
                    pg8::gemm_phase<EpiInA, pg8::StaticOrder, true, true>(lds, g, S, E, tid);
                } else if (s == 1) phase_attnA(p, lds, wid, lane, dry);
                else phase_combineA(p, bidx, tid);
            } else if (r == 7) {
                pg8::Gemm g{XG, (const bf16_t*)(ws + WS_WB_IN) + (size_t)pair * 4096 * 1024, MROWS, 4096, DM};
                pg8::StaticOrder S; S.init(MROWS, 4096, gridDim.x, blockIdx.x);
                EpiInB E{QKV, Zb, SSQ, cosB, sinB, 0.125f * LOG2E};
                pg8::gemm_phase<EpiInB, pg8::StaticOrder, true, true>(lds, g, S, E, tid);
            } else if (r == 8) phase_attnB(p, lds, pair, 2 * pair + 1, tid, wid, lane, dry);
            else {
                const bool isA = (r == 6);
                const int layer = 2 * pair + (isA ? 0 : 1);
                const bf16_t* Wt = (const bf16_t*)(ws + (isA ? WS_WA_OUT : WS_WB_OUT)) + (size_t)pair * 1024 * 1024;
                const float* gnext = isA ? p.b_norm + pair * DM : (layer == 3 ? (const float*)nullptr : p.a_norm + (pair + 1) * DM);
                pg8::Gemm g{Zb, Wt, MROWS, DM, DM};
                pg8::StaticOrder S; S.init(MROWS, DM, gridDim.x, blockIdx.x);
                EpiOut E{(layer == 0) ? p.x : (const float*)p.out, p.out, XG, gnext, SSQ};
                pg8::gemm_phase<EpiOut, pg8::StaticOrder, true, true>(lds, g, S, E, tid);
            }
        }
        }
        if (ph + 1 < hi) { if (ph == lo) { grid.sync(); xb = xcd_barrier_post(barw, bst); } else xcd_barrier(xb); }
    }
}

constexpr int N_PHASES = 22;
#ifndef MK_PER_PHASE
#define MK_PER_PHASE 0
#endif

extern "C" void kernel_launch(void* const* d_in, const int* in_sizes, int n_in, void* d_out, int out_size, void* d_ws, size_t ws_size, hipStream_t stream) {
    static int grid = 0;
    if (grid == 0) {
        int dev = 0, cus = 0, per_cu = 0;
        hipGetDevice(&dev);
        hipDeviceGetAttribute(&cus, hipDeviceAttributeMultiprocessorCount, dev);
        hipFuncSetAttribute((const void*)fwd_megakernel, hipFuncAttributeMaxDynamicSharedMemorySize, LDS_BYTES);
        hipOccupancyMaxActiveBlocksPerMultiprocessor(&per_cu, (const void*)fwd_megakernel, NTHREADS, LDS_BYTES);
        if (per_cu < 1) { fprintf(stderr, "kernel_launch: occupancy query says %d blocks per CU\n", per_cu); per_cu = 1; }
        (void)hipGetLastError();
        grid = cus * 1;
        if (ws_size < WS_END) { fprintf(stderr, "kernel_launch: workspace too small (%zu < %zu)\n", ws_size, (size_t)WS_END); grid = -1; }
    }
    if (grid < 0) return;
    Params p{};
    p.x = (const float*)d_in[0]; p.a_norm = (const float*)d_in[1]; p.a_w_in = (const float*)d_in[2]; p.a_w_out = (const float*)d_in[3];
    p.b_norm = (const float*)d_in[4]; p.b_w_in = (const float*)d_in[5]; p.b_lambda = (const float*)d_in[6]; p.b_subln = (const float*)d_in[7];
    p.b_w_out = (const float*)d_in[8]; p.final_norm = (const float*)d_in[9];
    p.out = (float*)d_out; p.ws = (unsigned char*)d_ws;
#if MK_PER_PHASE
    for (int ph = 0; ph < N_PHASES; ++ph) {
        p.ph_lo = ph; p.ph_hi = ph + 1;
        hipLaunchKernelGGL(fwd_megakernel, dim3(grid), dim3(NTHREADS), LDS_BYTES, stream, p);
    }
#else
    p.ph_lo = 0; p.ph_hi = N_PHASES;
    void* args[] = {&p};
    hipError_t e = hipLaunchCooperativeKernel((const void*)fwd_megakernel, dim3(grid), dim3(NTHREADS), args, LDS_BYTES, stream);
    if (e != hipSuccess) fprintf(stderr, "cooperative launch failed: %s (grid %d)\n", hipGetErrorString(e), grid);
#endif
}
```

```cpp
#include <hip/hip_runtime.h>
#include <hip/hip_cooperative_groups.h>
#include <cstdio>
#include <cstdint>
namespace cg = cooperative_groups;
namespace pg8 {
#define PG8_LAS __attribute__((address_space(3)))
typedef unsigned short bf16_t;
typedef short bf16x8 __attribute__((ext_vector_type(8)));
typedef float f32x4 __attribute__((ext_vector_type(4)));
typedef unsigned u32x4 __attribute__((ext_vector_type(4)));
constexpr int BM = 256, BK = 64, HALF = 128, HTB = HALF * BK * 2  , STAGE_BYTES = 8 * HTB, NXCD = 8, WGM = 8;

__host__ __device__ __forceinline__ int lds_byte(int r, int c) { const int st = (r >> 4) * 2 + (c >> 5), rr = r & 15, cc = c & 31, ob = rr * 64 + cc * 2; return st * 1024 + (ob ^ (((ob >> 9) & 1) << 5)); }
__host__ __device__ __forceinline__ void stage_rc(int b, int& R, int& C) { const int st = b / 1024, sb = b % 1024, swz = sb ^ (((sb >> 9) & 1) << 5); R = (st >> 1) * 16 + swz / 64; C = (st & 1) * 32 + (swz % 64) / 2; }
__host__ __device__ __forceinline__ int perm32(int rho) { const int n = rho >> 4, i = rho & 15; return 8 * (i >> 2) + 4 * n + (i & 3); }

struct Unit { int pm, pn; };
struct Gemm { const bf16_t* A; const bf16_t* Bt; int M, N, K; };

struct StaticOrder {
    int nM, nN, nwg, G, c;
    __host__ __device__ void init(int M, int N, int G_, int c_) { nM = M / BM; nN = N / BM; nwg = nM * nN; G = G_; c = c_; }
    __host__ __device__ bool next(int i, Unit& u) const {
        const long L = (long)i * G + c; if (L >= nwg) return false;
        int wgid = (int)L; { const int q = nwg / NXCD, r = nwg % NXCD, xcd = wgid % NXCD, off = wgid / NXCD; wgid = (xcd < r ? xcd * (q + 1) : r * (q + 1) + (xcd - r) * q) + off; }
        const int nig = WGM * nN, gid = wgid / nig, fm = gid * WGM, gsz = (nM - fm) < WGM ? (nM - fm) : WGM;
        u.pm = fm + ((wgid % nig) % gsz); u.pn = (wgid % nig) / gsz; return true;
    }
    __device__ __forceinline__ void a_ready(const Unit&) const {}
    __device__ __forceinline__ void done(const Unit&) const {}
};

__device__ __forceinline__ unsigned cvt_pk_bf16(float lo, float hi) { unsigned r; asm volatile("v_cvt_pk_bf16_f32 %0, %1, %2" : "=v"(r) : "v"(lo), "v"(hi)); return r; }
typedef float f32x2 __attribute__((ext_vector_type(2)));
template <class Epi, class Sched, bool ALIGN_EPI = false, bool SP2 = false>
__device__ __forceinline__ void gemm_phase(PG8_LAS unsigned char* lds, const Gemm g, const Sched& S, const Epi& E, const int tid) {
    const int wid = __builtin_amdgcn_readfirstlane(tid >> 6), lane = tid & 63, wr = wid >> 2, wc = wid & 3, fr = lane & 15, fq = lane >> 4;
    const int K = g.K, nt = K / BK;
    unsigned voffA[2], voffB[2];
#pragma unroll
    for (int i = 0; i < 2; ++i) { int R, C; stage_rc(tid * 16 + i * 8192, R, C); const int Rb = Epi::PERM ? ((R & ~31) + perm32(R & 31)) : R;
        voffA[i] = (unsigned)(R * K + C) * 2u; voffB[i] = (unsigned)(Rb * K + C) * 2u; }
    const size_t kstep = (size_t)(BK * 2);
    const size_t hstep = (size_t)HALF * K * 2;
    const size_t tstep = 2 * hstep;
    const unsigned ldsw = (unsigned)wid * 1024u;
    const int aoff = lds_byte(wr * 64 + fr, fq * 8), boff = lds_byte(wc * 32 + fr, fq * 8);
#define PG8_SA(b, h) (((b) * 2 + (h)) * HTB)
#define PG8_SB(b, h) ((4 + (b) * 2 + (h)) * HTB)
#define PG8_STAGE(bufoff, gbase, voff) do { _Pragma("unroll") for (int _i = 0; _i < 2; ++_i) \
        __builtin_amdgcn_global_load_lds((const unsigned*)((const char*)(gbase) + (voff)[_i]), (PG8_LAS unsigned*)(lds + (bufoff) + ldsw + _i * 8192), 16, 0, 0); } while (0)
#define PG8_LDA(dst, b, h) do { _Pragma("unroll") for (int m = 0; m < 4; ++m) _Pragma("unroll") for (int k = 0; k < 2; ++k) dst[m][k] = *(const PG8_LAS bf16x8*)(lds + PG8_SA(b, h) + aoff + m * 2048 + k * 1024); } while (0)
#define PG8_LDB(dst, b, h) do { _Pragma("unroll") for (int n = 0; n < 2; ++n) _Pragma("unroll") for (int k = 0; k < 2; ++k) dst[n][k] = *(const PG8_LAS bf16x8*)(lds + PG8_SB(b, h) + boff + n * 2048 + k * 1024); } while (0)
#define PG8_MMA(ai, bj, At, Bt) do { __builtin_amdgcn_s_setprio(1); _Pragma("unroll") for (int m = 0; m < 4; ++m) _Pragma("unroll") for (int n = 0; n < 2; ++n) _Pragma("unroll") for (int k = 0; k < 2; ++k) \
        acc[ai][bj][m][n] = __builtin_amdgcn_mfma_f32_16x16x32_bf16(Bt[n][k], At[m][k], acc[ai][bj][m][n], 0, 0, 0); __builtin_amdgcn_s_setprio(0); } while (0)
#define PG8_WAIT_V(n) asm volatile("s_waitcnt vmcnt(" #n ")" ::: "memory")
#define PG8_WAIT_L(n) asm volatile("s_waitcnt lgkmcnt(" #n ")" ::: "memory")
#define PG8_BAR __builtin_amdgcn_s_barrier()
#define PG8_SCHED __builtin_amdgcn_sched_barrier(0)
    Unit cur, nxt; int ui = 0;
    if (!S.next(0, cur)) return;
    f32x4 acc[2][2][4][2];
#pragma unroll
    for (int a = 0; a < 2; ++a)
#pragma unroll
        for (int b = 0; b < 2; ++b)
#pragma unroll
            for (int m = 0; m < 4; ++m)
#pragma unroll
                for (int n = 0; n < 2; ++n) acc[a][b][m][n] = (f32x4){0.f, 0.f, 0.f, 0.f};
    bf16x8 At[4][2], B0[2][2], B1[2][2];
    const char* cA = (const char*)g.A + (size_t)cur.pm * tstep; const char* cB = (const char*)g.Bt + (size_t)cur.pn * tstep;
    S.a_ready(cur);
    if constexpr (SP2) {
        PG8_STAGE(PG8_SB(0, 0), cB, voffB); PG8_STAGE(PG8_SB(0, 1), cB + hstep, voffB); PG8_STAGE(PG8_SA(0, 0), cA, voffA); PG8_STAGE(PG8_SA(0, 1), cA + hstep, voffA);
        if (wr == 1) PG8_BAR;
        PG8_WAIT_V(2); PG8_BAR;
        PG8_STAGE(PG8_SB(1, 0), cB + kstep, voffB); PG8_STAGE(PG8_SA(1, 0), cA + kstep, voffA); PG8_STAGE(PG8_SB(1, 1), cB + hstep + kstep, voffB);
        PG8_WAIT_V(6); PG8_BAR;
    } else {
        PG8_STAGE(PG8_SB(0, 0), cB, voffB); PG8_STAGE(PG8_SA(0, 0), cA, voffA); PG8_STAGE(PG8_SB(0, 1), cB + hstep, voffB); PG8_STAGE(PG8_SA(0, 1), cA + hstep, voffA);
        if (wr == 1) PG8_BAR;
        PG8_WAIT_V(4); PG8_BAR;
        PG8_STAGE(PG8_SB(1, 0), cB + kstep, voffB); PG8_STAGE(PG8_SA(1, 0), cA + kstep, voffA); PG8_STAGE(PG8_SB(1, 1), cB + hstep + kstep, voffB);
        PG8_WAIT_V(6); PG8_BAR;
    }
    for (;;) {
        const bool has_next = S.next(ui + 1, nxt);
        const char* nA = has_next ? (const char*)g.A + (size_t)nxt.pm * tstep : cA; const char* nB = has_next ? (const char*)g.Bt + (size_t)nxt.pn * tstep : cB;
        for (int t = 0; t < nt; t += 2) {
            const bool last = (t == nt - 2);
            const char* a1 = cA + (size_t)(t + 1) * kstep;
            const char* a2 = last ? nA : cA + (size_t)(t + 2) * kstep; const char* b2 = last ? nB : cB + (size_t)(t + 2) * kstep;
            const char* a3 = a2 + kstep; const char* b3 = b2 + kstep;
            if (last && has_next) S.a_ready(nxt);
            if constexpr (SP2) {
            PG8_LDB(B0, 0, 0); PG8_LDB(B1, 0, 1); PG8_SCHED; PG8_LDA(At, 0, 0); PG8_STAGE(PG8_SA(1, 1), a1 + hstep, voffA);
            PG8_WAIT_V(8); PG8_WAIT_L(0); PG8_BAR; PG8_MMA(0, 0, At, B0); PG8_MMA(0, 1, At, B1); PG8_BAR; PG8_SCHED;
            PG8_LDA(At, 0, 1); PG8_STAGE(PG8_SB(0, 0), b2, voffB); PG8_STAGE(PG8_SB(0, 1), b2 + hstep, voffB); PG8_STAGE(PG8_SA(0, 0), a2, voffA);
            PG8_WAIT_V(8); PG8_WAIT_L(0); PG8_BAR; PG8_MMA(1, 0, At, B0); PG8_MMA(1, 1, At, B1); PG8_BAR; PG8_SCHED;
            PG8_LDB(B0, 1, 0); PG8_LDB(B1, 1, 1); PG8_SCHED; PG8_LDA(At, 1, 0); PG8_STAGE(PG8_SA(0, 1), a2 + hstep, voffA);
            PG8_WAIT_V(8); PG8_WAIT_L(0); PG8_BAR; PG8_MMA(0, 0, At, B0); PG8_MMA(0, 1, At, B1); PG8_BAR; PG8_SCHED;
            PG8_LDA(At, 1, 1); PG8_STAGE(PG8_SB(1, 0), b3, voffB); PG8_STAGE(PG8_SB(1, 1), b3 + hstep, voffB); PG8_STAGE(PG8_SA(1, 0), a3, voffA);
            PG8_WAIT_V(8); PG8_WAIT_L(0); PG8_BAR; PG8_MMA(1, 0, At, B0); PG8_MMA(1, 1, At, B1); PG8_BAR; PG8_SCHED;
            } else {
            PG8_LDB(B0, 0, 0); PG8_SCHED; PG8_LDA(At, 0, 0); PG8_STAGE(PG8_SA(1, 1), a1 + hstep, voffA);
            PG8_WAIT_L(8); PG8_BAR; PG8_WAIT_L(0); PG8_MMA(0, 0, At, B0); PG8_BAR; PG8_SCHED;
            PG8_LDB(B1, 0, 1); PG8_STAGE(PG8_SB(0, 0), b2, voffB);
            PG8_BAR; PG8_WAIT_L(0); PG8_MMA(0, 1, At, B1); PG8_BAR;
            PG8_LDA(At, 0, 1); PG8_STAGE(PG8_SA(0, 0), a2, voffA);
            PG8_BAR; PG8_WAIT_L(0); PG8_MMA(1, 0, At, B0); PG8_BAR; PG8_SCHED;
            PG8_STAGE(PG8_SB(0, 1), b2 + hstep, voffB);
            PG8_WAIT_V(6); PG8_BAR; PG8_MMA(1, 1, At, B1); PG8_BAR;
            PG8_LDB(B0, 1, 0); PG8_SCHED; PG8_LDA(At, 1, 0); PG8_STAGE(PG8_SA(0, 1), a2 + hstep, voffA);
            PG8_WAIT_L(8); PG8_BAR; PG8_WAIT_L(0); PG8_MMA(0, 0, At, B0); PG8_BAR; PG8_SCHED;
            PG8_LDB(B1, 1, 1); PG8_STAGE(PG8_SB(1, 0), b3, voffB);
            PG8_BAR; PG8_WAIT_L(0); PG8_MMA(0, 1, At, B1); PG8_BAR;
            PG8_LDA(At, 1, 1); PG8_STAGE(PG8_SA(1, 0), a3, voffA);
            PG8_BAR; PG8_WAIT_L(0); PG8_MMA(1, 0, At, B0); PG8_BAR; PG8_SCHED;
            PG8_STAGE(PG8_SB(1, 1), b3 + hstep, voffB);
            PG8_WAIT_V(6); PG8_BAR; PG8_MMA(1, 1, At, B1); PG8_BAR;
            }
        }
        if constexpr (ALIGN_EPI) { if (wr == 0) PG8_BAR; }
        if constexpr (!Epi::AFTER_DRAIN) { E(acc, cur, wr, wc, fr, fq); S.done(cur); }
        if (!has_next) break;
#pragma unroll
        for (int a = 0; a < 2; ++a)
#pragma unroll
            for (int b = 0; b < 2; ++b)
#pragma unroll
                for (int m = 0; m < 4; ++m)
#pragma unroll
                    for (int n = 0; n < 2; ++n) acc[a][b][m][n] = (f32x4){0.f, 0.f, 0.f, 0.f};
        cur = nxt; cA = nA; cB = nB; ++ui;
        if constexpr (ALIGN_EPI) { if (wr == 1) PG8_BAR; }
    }
    PG8_WAIT_V(0);
    if constexpr (!ALIGN_EPI) { if (wr == 0) PG8_BAR; }
    PG8_BAR;
    if constexpr (Epi::AFTER_DRAIN) { E.fused(acc, cur, wr, wc, fr, fq, lds, wid, lane); S.done(cur); }
#undef PG8_SA
#undef PG8_SB
#undef PG8_STAGE
#undef PG8_LDA
#undef PG8_LDB
#undef PG8_MMA
#undef PG8_WAIT_V
#undef PG8_WAIT_L
#undef PG8_BAR
#undef PG8_SCHED
}
}

#define DI __device__ __forceinline__
#define LAS __attribute__((address_space(3)))
typedef unsigned short bf16_t;
typedef short bf16x8 __attribute__((ext_vector_type(8)));
typedef short s16x4 __attribute__((ext_vector_type(4)));
typedef float f32x4 __attribute__((ext_vector_type(4)));
typedef float f32x16 __attribute__((ext_vector_type(16)));
typedef unsigned u32x4 __attribute__((ext_vector_type(4)));
typedef unsigned u32x2 __attribute__((ext_vector_type(2)));
typedef float f32x2_t __attribute__((ext_vector_type(2)));
typedef __bf16 bf16x2_t __attribute__((ext_vector_type(2)));
typedef short v4i16_t __attribute__((ext_vector_type(4)));

constexpr int SEQ = 8192, DM = 1024, MROWS = 16384;
constexpr int NWAVES = 8, NTHREADS = 512;
constexpr int LDS_BYTES = 155648;
constexpr float EPS = 1e-6f;
constexpr float LOG2E = 1.4426950408889634f, LN2 = 0.6931471805599453f;
constexpr float NEGB = -1e30f;

constexpr size_t MiB = 1u << 20;
constexpr size_t WS_WA_IN = 0, WS_WB_IN = 40 * MiB, WS_WA_OUT = 56 * MiB, WS_WB_OUT = 60 * MiB;
constexpr size_t WS_XG = 64 * MiB, WS_Z = 96 * MiB, WS_QKV = 128 * MiB;
constexpr size_t WS_SSQ = 272 * MiB, WS_LSE = 273 * MiB, WS_ROPE = 274 * MiB, WS_BAR = 276 * MiB, WS_END = 277 * MiB;

struct Params {
    const float* x; const float* a_norm; const float* a_w_in; const float* a_w_out;
    const float* b_norm; const float* b_w_in; const float* b_lambda; const float* b_subln; const float* b_w_out; const float* final_norm;
    float* out; unsigned char* ws; int ph_lo, ph_hi;
};

DI unsigned cvtpk(float lo, float hi) { f32x2_t v = {lo, hi}; bf16x2_t b = __builtin_convertvector(v, bf16x2_t); return __builtin_bit_cast(unsigned, b); }
DI float bf2f(unsigned short b) { return __uint_as_float(((unsigned)b) << 16); }
DI int crow(int r, int hi) { return (r & 3) + 8 * (r >> 2) + 4 * hi; }
DI s16x4 vtr(const LAS char* p) { return __builtin_bit_cast(s16x4, __builtin_amdgcn_ds_read_tr16_b64_v4i16((LAS v4i16_t*)p)); }
DI float fexp2(float x) { return __builtin_amdgcn_exp2f(x); }
DI float silu(float z) { return z / (1.f + __expf(-z)); }
DI float wave_sum(float v) {
#pragma unroll
    for (int o = 1; o < 64; o <<= 1) v += __shfl_xor(v, o);
    return v;
}
#define MFMA32(a, b, c) __builtin_amdgcn_mfma_f32_32x32x16_bf16((a), (b), (c), 0, 0, 0)

using pg8::Unit;
struct EpiInA {
    static constexpr bool PERM = true, AFTER_DRAIN = false;
    bf16_t* qkv; bf16_t* z; const float* ssq; const float* cs; const float* sn; float qscale;
    DI void operator()(const f32x4 (&acc)[2][2][4][2], const Unit& u, int wr, int wc, int fr, int fq) const {
        const int ct = u.pn; bf16_t* base; int kind;
        if (ct < 36) { const int g = ct / 12, t = (ct % 12) >> 2; kind = t; base = qkv + (size_t)(g * 3 + t) * ((size_t)SEQ * DM) + (ct & 3) * 256; }
        else { kind = 3; base = z + (ct - 36) * 256; }
        const bool rot = (kind < 2) && (wc == 0);
        const float osc = (kind == 0) ? qscale : 1.f;
#pragma unroll
        for (int ai = 0; ai < 2; ++ai)
#pragma unroll
            for (int m = 0; m < 4; ++m) {
                const int row = u.pm * 256 + ai * 128 + wr * 64 + m * 16 + fr;
                const f32x4* sp = (const f32x4*)(ssq + (size_t)row * 16);
                const f32x4 pa = sp[0], pb = sp[1], pc = sp[2], pd = sp[3];
                const float ss = (((pa.x + pa.y) + (pa.z + pa.w)) + ((pb.x + pb.y) + (pb.z + pb.w))) + (((pc.x + pc.y) + (pc.z + pc.w)) + ((pd.x + pd.y) + (pd.z + pd.w)));
                const float rs = 1.0f / sqrtf(ss * (1.0f / DM) + EPS);
                f32x4 c0 = {1.f, 1.f, 1.f, 1.f}, c1 = c0, s0 = {0.f, 0.f, 0.f, 0.f}, s1 = s0;
                if (rot) { const int ib = row * 16 + 8 * (fq & 1); c0 = *(const f32x4*)(cs + ib); c1 = *(const f32x4*)(cs + ib + 4); s0 = *(const f32x4*)(sn + ib); s1 = *(const f32x4*)(sn + ib + 4);
                           if (fq < 2) { s0 = -s0; s1 = -s1; } }
#pragma unroll
                for (int bj = 0; bj < 2; ++bj) {
                    f32x4 v0 = acc[ai][bj][m][0] * rs, v1 = acc[ai][bj][m][1] * rs;
                    if (rot) {
                        f32x4 p0, p1;
#pragma unroll
                        for (int j = 0; j < 4; ++j) { p0[j] = __shfl_xor(v0[j], 32); p1[j] = __shfl_xor(v1[j], 32); }
                        v0 = v0 * c0 + p0 * s0; v1 = v1 * c1 + p1 * s1;
                    }
                    v0 = v0 * osc; v1 = v1 * osc;
                    u32x4 w; w.x = cvtpk(v0[0], v0[1]); w.y = cvtpk(v0[2], v0[3]); w.z = cvtpk(v1[0], v1[1]); w.w = cvtpk(v1[2], v1[3]);
                    *(u32x4*)(base + (size_t)row * DM + bj * 128 + wc * 32 + 8 * fq) = w;
                }
            }
    }
};
struct EpiInB {
    static constexpr bool PERM = true, AFTER_DRAIN = false;
    bf16_t* qkv; bf16_t* z; const float* ssq; const float* cs; const float* sn; float qscale;
    DI void operator()(const f32x4 (&acc)[2][2][4][2], const Unit& u, int wr, int wc, int fr, int fq) const {
        const int ct = u.pn; const int kind = ct >> 2;
        bf16_t* base = (kind < 3 ? qkv + (size_t)kind * ((size_t)MROWS * DM) : z) + (ct & 3) * 256;
        const bool rot = (kind < 2) && ((wc & 1) == 0);
        const float osc = (kind == 0) ? qscale : 1.f;
#pragma unroll
        for (int ai = 0; ai < 2; ++ai)
#pragma unroll
            for (int m = 0; m < 4; ++m) {
                const int row = u.pm * 256 + ai * 128 + wr * 64 + m * 16 + fr;
                const f32x4* sp = (const f32x4*)(ssq + (size_t)row * 16);
                const f32x4 pa = sp[0], pb = sp[1], pc = sp[2], pd = sp[3];
                const float ss = (((pa.x + pa.y) + (pa.z + pa.w)) + ((pb.x + pb.y) + (pb.z + pb.w))) + (((pc.x + pc.y) + (pc.z + pc.w)) + ((pd.x + pd.y) + (pd.z + pd.w)));
                const float rs = 1.0f / sqrtf(ss * (1.0f / DM) + EPS);
                f32x4 c0 = {1.f, 1.f, 1.f, 1.f}, c1 = c0, s0 = {0.f, 0.f, 0.f, 0.f}, s1 = s0;
                if (rot && fq < 2) { const int ib = (row & (SEQ - 1)) * 8; c0 = *(const f32x4*)(cs + ib); c1 = *(const f32x4*)(cs + ib + 4); s0 = *(const f32x4*)(sn + ib); s1 = *(const f32x4*)(sn + ib + 4);
                                     if (fq == 0) { s0 = -s0; s1 = -s1; } }
#pragma unroll
                for (int bj = 0; bj < 2; ++bj) {
                    f32x4 v0 = acc[ai][bj][m][0] * rs, v1 = acc[ai][bj][m][1] * rs;
                    if (rot) {
                        f32x4 p0, p1;
#pragma unroll
                        for (int j = 0; j < 4; ++j) { p0[j] = __shfl_xor(v0[j], 16); p1[j] = __shfl_xor(v1[j], 16); }
                        v0 = v0 * c0 + p0 * s0; v1 = v1 * c1 + p1 * s1;
                    }
                    v0 = v0 * osc; v1 = v1 * osc;
                    u32x4 w; w.x = cvtpk(v0[0], v0[1]); w.y = cvtpk(v0[2], v0[3]); w.z = cvtpk(v1[0], v1[1]); w.w = cvtpk(v1[2], v1[3]);
                    *(u32x4*)(base + (size_t)row * DM + bj * 128 + wc * 32 + 8 * fq) = w;
                }
            }
    }
};
struct EpiOut {
    static constexpr bool PERM = false, AFTER_DRAIN = false;
    const float* xin; float* xout; bf16_t* xg; const float* gnext; float* ssq;
    DI void operator()(const f32x4 (&acc)[2][2][4][2], const Unit& u, int wr, int wc, int fr, int fq) const {
#pragma unroll
        for (int ai = 0; ai < 2; ++ai)
#pragma unroll
            for (int m = 0; m < 4; ++m) {
                const int row = u.pm * 256 + ai * 128 + wr * 64 + m * 16 + fr;
                float ss = 0.f;
#pragma unroll
                for (int bj = 0; bj < 2; ++bj)
#pragma unroll
                    for (int n = 0; n < 2; ++n) {
                        const int col = u.pn * 256 + bj * 128 + wc * 32 + n * 16 + 4 * fq;
                        const size_t off = (size_t)row * DM + col;
                        const f32x4 v = *(const f32x4*)(xin + off) + acc[ai][bj][m][n];
                        *(f32x4*)(xout + off) = v;
                        ss += (v.x * v.x + v.y * v.y) + (v.z * v.z + v.w * v.w);
                        if (gnext) { const f32x4 g4 = *(const f32x4*)(gnext + col); u32x2 w; w.x = cvtpk(v.x * g4.x, v.y * g4.y); w.y = cvtpk(v.z * g4.z, v.w * g4.w); *(u32x2*)(xg + off) = w; }
                    }
                ss += __shfl_xor(ss, 16); ss += __shfl_xor(ss, 32);
                if (fq == 0) ssq[(size_t)row * 16 + u.pn * 4 + wc] = ss;
            }
    }
};

DI unsigned f2bf(float f) { unsigned u = __builtin_bit_cast(unsigned, f); return (u + 0x7fffu + ((u >> 16) & 1u)) >> 16; }
DI unsigned pk2(float lo, float hi) { return f2bf(lo) | (f2bf(hi) << 16); }
DI void transpose_item(const float* W, int K, int N, bf16_t* WT, LAS float* scr, int item, int lane) {
    const int nblk = N / 32, kb = item / nblk, nb = item % nblk, k0 = 64 * kb, n0 = 32 * nb;
#pragma unroll 8
    for (int i = 0; i < 32; ++i) { const int kk = 2 * i + (lane >> 5); scr[kk * 33 + (lane & 31)] = W[(size_t)(k0 + kk) * N + n0 + (lane & 31)]; }
    asm volatile("s_waitcnt lgkmcnt(0)" ::: "memory");
    const int c = lane & 7;
#pragma unroll
    for (int j = 0; j < 4; ++j) { const int n = (lane >> 3) + 8 * j; const LAS float* s = scr + (8 * c) * 33 + n;
        u32x4 o; o.x = pk2(s[0 * 33], s[1 * 33]); o.y = pk2(s[2 * 33], s[3 * 33]); o.z = pk2(s[4 * 33], s[5 * 33]); o.w = pk2(s[6 * 33], s[7 * 33]);
        *(u32x4*)(WT + (size_t)(n0 + n) * K + k0 + 8 * c) = o; }
    asm volatile("s_waitcnt lgkmcnt(0)" ::: "memory");
}

__constant__ float ROPE_INV[16] = {1.0f, 0.44036662578582764f, 0.193922758102417f, 0.08539710193872452f, 0.03760603070259094f, 0.016560440883040428f, 0.00729266507551074f, 0.0032114461064338684f,
                                   0.001414213445968926f, 0.0006227724370546639f, 0.00027424818836152554f, 0.00012076974235242233f, 5.318296462064609e-05f, 2.3419997887685895e-05f, 1.0313385246263351e-05f, 4.541670477919979e-06f};
DI void phase_prologue(const Params& p, LAS unsigned char* lds, int tid, int wid, int lane) {
    unsigned char* ws = p.ws;
    LAS float* scr = (LAS float*)(lds + wid * 16384);
    const int gw = blockIdx.x * NWAVES + wid, NGW = gridDim.x * NWAVES;
    constexpr int I_AIN = 16 * 320, I_OUT = 16 * 32, I_BIN = 16 * 128, PER_J = I_AIN + 2 * I_OUT + I_BIN;
    for (int it = gw; it < 2 * PER_J; it += NGW) {
        const int j = it / PER_J; int r = it % PER_J;
        if (r < I_AIN) { transpose_item(p.a_w_in + (size_t)j * 1024 * 10240, 1024, 10240, (bf16_t*)(ws + WS_WA_IN) + (size_t)j * 10240 * 1024, scr, r, lane); continue; } r -= I_AIN;
        if (r < I_OUT) { transpose_item(p.a_w_out + (size_t)j * 1024 * 1024, 1024, 1024, (bf16_t*)(ws + WS_WA_OUT) + (size_t)j * 1024 * 1024, scr, r, lane); continue; } r -= I_OUT;
        if (r < I_BIN) { transpose_item(p.b_w_in + (size_t)j * 1024 * 4096, 1024, 4096, (bf16_t*)(ws + WS_WB_IN) + (size_t)j * 4096 * 1024, scr, r, lane); continue; } r -= I_BIN;
        transpose_item(p.b_w_out + (size_t)j * 1024 * 1024, 1024, 1024, (bf16_t*)(ws + WS_WB_OUT) + (size_t)j * 1024 * 1024, scr, r, lane);
    }
    bf16_t* xg = (bf16_t*)(ws + WS_XG); float* ssq = (float*)(ws + WS_SSQ);
    for (int m = gw; m < MROWS; m += NGW) {
        const f32x4* xr = (const f32x4*)(p.x + (size_t)m * DM) + lane; const f32x4* gr = (const f32x4*)p.a_norm + lane;
        float s = 0.f;
#pragma unroll
        for (int j = 0; j < 4; ++j) { const f32x4 v = xr[64 * j], g = gr[64 * j]; s += (v.x * v.x + v.y * v.y) + (v.z * v.z + v.w * v.w);
            u32x2 w; w.x = cvtpk(v.x * g.x, v.y * g.y); w.y = cvtpk(v.z * g.z, v.w * g.w); *((u32x2*)(xg + (size_t)m * DM) + lane + 64 * j) = w; }
        s = wave_sum(s);
        if (lane < 16) ssq[(size_t)m * 16 + lane] = (lane == 0) ? s : 0.f;
    }
    float* cosA = (float*)(ws + WS_ROPE); float* sinA = cosA + SEQ * 16; float* cosB = sinA + SEQ * 16; float* sinB = cosB + SEQ * 8;
    for (int idx = blockIdx.x * NTHREADS + tid; idx < SEQ * 24; idx += gridDim.x * NTHREADS) {
        int pos, i, rotd; float* cd; float* sd;
        if (idx < SEQ * 16) { pos = idx >> 4; i = idx & 15; rotd = 32; cd = cosA + idx; sd = sinA + idx; }
        else { const int k = idx - SEQ * 16; pos = k >> 3; i = k & 7; rotd = 16; cd = cosB + k; sd = sinB + k; }
        const float inv = ROPE_INV[(rotd == 32) ? i : 2 * i];
        const float ang = (float)pos * inv;
        const double rev = (double)ang * 0.15915494309189535;
        const double fr = rev - rint(rev);
        *cd = __builtin_amdgcn_cosf((float)fr); *sd = __builtin_amdgcn_sinf((float)fr);
    }
}

constexpr int AW_K = 0, AW_V = 8704, AW_BYTES = 18944;
DI void attnA_item(LAS char* wl, bf16_t* Qb, const bf16_t* Kb, const bf16_t* Vb, float* lse, int r, int rho, int c, int h, int lane, bool dry) {
    const int q = lane & 31, hh = lane >> 5, lr = lane >> 4, lc = lane & 15;
    const int tq = rho + r * (32 * c + q);
    bf16_t* Qrow = Qb + (size_t)tq * DM + h * 128;
    bf16x8 qf[8];
#pragma unroll
    for (int st = 0; st < 8; ++st) qf[st] = *(const bf16x8*)(Qrow + 16 * st + 8 * hh);
    f32x16 o[4];
#pragma unroll
    for (int db = 0; db < 4; ++db)
#pragma unroll
        for (int i = 0; i < 16; ++i) o[db][i] = 0.f;
    float m_run = NEGB, l_run = 0.f;
    const int t_lo = (c - 4 > 0) ? c - 4 : 0;
    u32x4 kreg[8], vreg[8];
    {
        const size_t tok0 = (size_t)(rho + r * (32 * t_lo + lr));
#pragma unroll
        for (int it = 0; it < 8; ++it) { const size_t off = (tok0 + (size_t)r * 4 * it) * DM + h * 128 + lc * 8; kreg[it] = *(const u32x4*)(Kb + off); vreg[it] = *(const u32x4*)(Vb + off); }
    }
    const LAS char* vb = wl + AW_V + (4 * hh + (lc >> 2)) * 320 + (lr & 1) * 32 + (lane & 3) * 8;
    for (int t = t_lo; t <= c; ++t) {
#pragma unroll
        for (int it = 0; it < 8; ++it) { *(LAS u32x4*)(wl + AW_K + (4 * it + lr) * 272 + lc * 16) = kreg[it]; *(LAS u32x4*)(wl + AW_V + (4 * it + lr) * 320 + lc * 16) = vreg[it]; }
        if (t < c) {
            const size_t tok0 = (size_t)(rho + r * (32 * (t + 1) + lr));
#pragma unroll
            for (int it = 0; it < 8; ++it) { const size_t off = (tok0 + (size_t)r * 4 * it) * DM + h * 128 + lc * 8; kreg[it] = *(const u32x4*)(Kb + off); vreg[it] = *(const u32x4*)(Vb + off); }
        }
        f32x16 s;
#pragma unroll
        for (int i = 0; i < 16; ++i) s[i] = 0.f;
#pragma unroll
        for (int st = 0; st < 8; ++st) { const bf16x8 a = *(const LAS bf16x8*)(wl + AW_K + q * 272 + st * 32 + hh * 16); s = MFMA32(a, qf[st], s); }
        if (t == c) {
#pragma unroll
            for (int i = 0; i < 16; ++i) if (crow(i, hh) > q) s[i] = NEGB;
        }
        if (t == c - 4) {
#pragma unroll
            for (int i = 0; i < 16; ++i) if (crow(i, hh) < q) s[i] = NEGB;
        }
        float mx = s[0];
#pragma unroll
        for (int i = 1; i < 16; ++i) mx = fmaxf(mx, s[i]);
        mx = fmaxf(mx, __shfl_xor(mx, 32));
        const float m_new = fmaxf(m_run, mx);
        const float alpha = fexp2(m_run - m_new);
        m_run = m_new;
        float ps = 0.f;
#pragma unroll
        for (int i = 0; i < 16; ++i) { s[i] = fexp2(s[i] - m_new); ps += s[i]; }
        l_run = l_run * alpha + ps;
#pragma unroll
        for (int db = 0; db < 4; ++db)
#pragma unroll
            for (int i = 0; i < 16; ++i) o[db][i] *= alpha;
        bf16x8 pf[2];
#pragma unroll
        for (int s2 = 0; s2 < 2; ++s2) { u32x4 w; w.x = cvtpk(s[8 * s2], s[8 * s2 + 1]); w.y = cvtpk(s[8 * s2 + 2], s[8 * s2 + 3]); w.z = cvtpk(s[8 * s2 + 4], s[8 * s2 + 5]); w.w = cvtpk(s[8 * s2 + 6], s[8 * s2 + 7]); pf[s2] = __builtin_bit_cast(bf16x8, w); }
#pragma unroll
        for (int db = 0; db < 4; ++db)
#pragma unroll
            for (int s2 = 0; s2 < 2; ++s2) {
                const s16x4 lo = vtr(vb + (16 * s2) * 320 + db * 64), hi = vtr(vb + (16 * s2 + 8) * 320 + db * 64);
                const bf16x8 a = (bf16x8){lo[0], lo[1], lo[2], lo[3], hi[0], hi[1], hi[2], hi[3]};
                o[db] = MFMA32(a, pf[s2], o[db]);
            }
    }
    const float l_tot = l_run + __shfl_xor(l_run, 32);
    const float inv = 1.0f / l_tot;
    if (dry) return;
#pragma unroll
    for (int db = 0; db < 4; ++db)
#pragma unroll
        for (int i4 = 0; i4 < 4; ++i4) {
            u32x2 w; w.x = cvtpk(o[db][4 * i4] * inv, o[db][4 * i4 + 1] * inv); w.y = cvtpk(o[db][4 * i4 + 2] * inv, o[db][4 * i4 + 3] * inv);
            *(u32x2*)(Qrow + 32 * db + 8 * i4 + 4 * hh) = w;
        }
    if (hh == 0) lse[(size_t)tq * 8 + h] = (m_run + __log2f(l_tot)) * LN2;
}

DI void phase_attnA(const Params& p, LAS unsigned char* lds, int wid, int lane, bool dry) {
    bf16_t* qkv = (bf16_t*)(p.ws + WS_QKV); float* lse = (float*)(p.ws + WS_LSE);
    LAS char* wl = (LAS char*)lds + wid * AW_BYTES;
    const int gw = blockIdx.x * NWAVES + wid, NGW = gridDim.x * NWAVES;
    for (int id = gw; id < 3 * 2048; id += NGW) {
        const int g = id >> 11, rem = id & 2047, h = rem >> 8, cc = rem & 255;
        const int r = (g == 0) ? 1 : (g == 1) ? 4 : 16;
        const int cpr = 256 / r;
        const int rho = cc / cpr, c = cc % cpr;
        bf16_t* Qb = qkv + (size_t)(g * 3 + 0) * ((size_t)SEQ * DM);
        const bf16_t* Kb = qkv + (size_t)(g * 3 + 1) * ((size_t)SEQ * DM);
        const bf16_t* Vb = qkv + (size_t)(g * 3 + 2) * ((size_t)SEQ * DM);
        attnA_item(wl, Qb, Kb, Vb, lse + (size_t)g * SEQ * 8, r, rho, c, h, lane, dry);
    }
}

DI void phase_combineA(const Params& p, int bidx, int tid) {
    const bf16_t* qkv = (const bf16_t*)(p.ws + WS_QKV); const float* lse = (const float*)(p.ws + WS_LSE);
    bf16_t* zb = (bf16_t*)(p.ws + WS_Z) + (size_t)bidx * SEQ * DM;
    for (int idx = blockIdx.x * NTHREADS + tid; idx < SEQ * 128; idx += gridDim.x * NTHREADS) {
        const int row = idx >> 7, ch = idx & 127, head = ch >> 4;
        const float l0 = lse[(size_t)row * 8 + head], l1 = lse[(size_t)(SEQ + row) * 8 + head], l2 = lse[(size_t)(2 * SEQ + row) * 8 + head];
        const float mx = fmaxf(l0, fmaxf(l1, l2));
        float e0 = __expf(l0 - mx), e1 = __expf(l1 - mx), e2 = __expf(l2 - mx);
        const float inv = 1.0f / (e0 + e1 + e2); e0 *= inv; e1 *= inv; e2 *= inv;
        const size_t off = (size_t)row * DM + ch * 8;
        const u32x4 a0 = *(const u32x4*)(qkv + off), a1 = *(const u32x4*)(qkv + (size_t)3 * SEQ * DM + off), a2 = *(const u32x4*)(qkv + (size_t)6 * SEQ * DM + off);
        const u32x4 zz = *(const u32x4*)(zb + off);
        u32x4 w;
#pragma unroll
        for (int k = 0; k < 4; ++k) {
            const float o_lo = e0 * __uint_as_float(a0[k] << 16) + e1 * __uint_as_float(a1[k] << 16) + e2 * __uint_as_float(a2[k] << 16);
            const float o_hi = e0 * __uint_as_float(a0[k] & 0xffff0000u) + e1 * __uint_as_float(a1[k] & 0xffff0000u) + e2 * __uint_as_float(a2[k] & 0xffff0000u);
            const float z_lo = __uint_as_float(zz[k] << 16), z_hi = __uint_as_float(zz[k] & 0xffff0000u);
            w[k] = cvtpk(o_lo * silu(z_lo), o_hi * silu(z_hi));
        }
        *(u32x4*)(zb + off) = w;
    }
}

constexpr int BB_SLOT = 16384, BB_VB = 3 * BB_SLOT;
constexpr float BB_THR = 8.0f;
#define SBAR() __builtin_amdgcn_sched_barrier(0)
DI void dma16(const void* sbase, unsigned voff, unsigned lds_dst) {
    unsigned keep;
    asm volatile("s_mov_b32 %0, m0\n\ts_mov_b32 m0, %3\n\ts_nop 0\n\tglobal_load_lds_dwordx4 %1, %2\n\ts_mov_b32 m0, %0" : "=&s"(keep) : "v"(voff), "s"(sbase), "s"(lds_dst) : "memory");
}
DI void attnB_unit(LAS char* lds, const bf16_t* Q, const bf16_t* K, const bf16_t* V, bf16_t* Z, const float* subln, int b, int h, int qb, float lam, float oscale, int tid, int wid, int lane, bool dry) {
    const int strm = wid >> 2, wq = wid & 3, q = lane & 31, hh = lane >> 5;
    const int q0 = qb * 128 + wq * 32;
    const size_t rowbase = (size_t)b * SEQ;
    const char* Qb = (const char*)(Q + (rowbase + q0) * DM + h * 128 + strm * 64);
    unsigned qoff = (unsigned)(q * DM + 8 * hh) * 2u; asm volatile("" : "+v"(qoff));
    bf16x8 qf[4];
#pragma unroll
    for (int st = 0; st < 4; ++st) qf[st] = *(const bf16x8*)(Qb + 32 * st + qoff);
    f32x16 o[4], negm;
#pragma unroll
    for (int db = 0; db < 4; ++db)
#pragma unroll
        for (int i = 0; i < 16; ++i) o[db][i] = 0.f;
    float mhat = 0.f, l_run = 0.f;
    const int NT = 2 * qb + 2, NTw = (q0 >> 6) + 1;
    const char* Kg = (const char*)(K + rowbase * DM + h * 128); const char* Vg = (const char*)(V + rowbase * DM + h * 128);
    const int drow = 4 * wid + (lane >> 4), dpc = lane & 15;
    unsigned voffK = (unsigned)(drow * (DM * 2) + ((dpc ^ (drow & 15)) * 16)); asm volatile("" : "+v"(voffK));
    unsigned voffV = (unsigned)(drow * (DM * 2) + ((dpc ^ ((drow & 3) << 2)) * 16)); asm volatile("" : "+v"(voffV));
    const unsigned ldsb = (unsigned)(size_t)lds;
    const unsigned dstw = ldsb + (unsigned)wid * 1024u;
#define BB_DMAK(t, slot) do { const char* b_ = Kg + (size_t)(t) * (64 * DM * 2); const unsigned d_ = (unsigned)__builtin_amdgcn_readfirstlane(dstw + (slot) * BB_SLOT); dma16(b_, voffK, d_); dma16(b_ + 32 * DM * 2, voffK, d_ + 8192u); } while (0)
#define BB_DMAV(t, slot) do { const char* b_ = Vg + (size_t)(t) * (64 * DM * 2); const unsigned d_ = (unsigned)__builtin_amdgcn_readfirstlane(dstw + BB_VB + (slot) * BB_SLOT); dma16(b_, voffV, d_); dma16(b_ + 32 * DM * 2, voffV, d_ + 8192u); } while (0)
#define BB_WAITBAR(N) asm volatile("s_waitcnt vmcnt(" #N ") lgkmcnt(0)\n\ts_barrier" ::: "memory")
    const int kp0 = ((strm * 8 + hh) ^ (q & 15)) * 16;
    int kq0 = q * 256 + kp0, kq1 = q * 256 + (kp0 ^ 32), kq2 = q * 256 + (kp0 ^ 64), kq3 = q * 256 + (kp0 ^ 96);
    asm volatile("" : "+v"(kq0), "+v"(kq1), "+v"(kq2), "+v"(kq3));
    const int q4 = (lane & 15) >> 2, vrest = (4 * hh + q4) * 256 + ((lane >> 4) & 1) * 32 + ((lane & 3) >> 1) * 16 + (lane & 1) * 8;
    int vq0 = BB_VB + vrest + ((0 ^ q4) * 64), vq1 = BB_VB + vrest + ((1 ^ q4) * 64), vq2 = BB_VB + vrest + ((2 ^ q4) * 64), vq3 = BB_VB + vrest + ((3 ^ q4) * 64);
    asm volatile("" : "+v"(vq0), "+v"(vq1), "+v"(vq2), "+v"(vq3));
#define BB_MASK(P0, P1, t) do { int qh_ = q0 + q - 64 * (t) - 4 * hh; asm volatile("" : "+v"(qh_));   \
        _Pragma("unroll") for (int i = 0; i < 16; ++i) { const int c_ = (i & 3) + 8 * (i >> 2); if (c_ > qh_) P0[i] = NEGB; if (c_ + 32 > qh_) P1[i] = NEGB; } } while (0)
#define BB_ROWMAX(P0, P1, rm) do { float a_ = fmaxf(fmaxf(P0[0], P0[1]), P1[0]), b_ = fmaxf(fmaxf(P0[2], P0[3]), P1[1]); a_ = fmaxf(fmaxf(a_, P1[2]), P1[3]); \
        _Pragma("unroll") for (int r = 4; r < 16; r += 4) { a_ = fmaxf(fmaxf(a_, P0[r]), P0[r + 1]); b_ = fmaxf(fmaxf(b_, P0[r + 2]), P0[r + 3]); a_ = fmaxf(fmaxf(a_, P1[r]), P1[r + 1]); b_ = fmaxf(fmaxf(b_, P1[r + 2]), P1[r + 3]); } \
        rm = fmaxf(a_, b_); { const auto rr_ = __builtin_amdgcn_permlane32_swap(__float_as_uint(rm), __float_as_uint(rm), false, false); rm = fmaxf(__uint_as_float(rr_[0]), __uint_as_float(rr_[1])); } } while (0)
#define BB_EXP2(P, B) do { P[B] = fexp2(P[B]); P[B + 1] = fexp2(P[B + 1]); } while (0)
#define BB_EXP4(P, B) do { P[B] = fexp2(P[B] - mhat); P[B + 1] = fexp2(P[B + 1] - mhat); P[B + 2] = fexp2(P[B + 2] - mhat); P[B + 3] = fexp2(P[B + 3] - mhat); } while (0)
#define BB_PACK(P, B) (u32x4){cvtpk(P[B], P[B + 1]), cvtpk(P[B + 2], P[B + 3]), cvtpk(P[B + 4], P[B + 5]), cvtpk(P[B + 6], P[B + 7])}
#define BB_KRD(KQ, ROWS) (*(const LAS bf16x8*)(lds + ks_ + (KQ) + (ROWS) * 256))
#define BB_VRD(L, H, S2, DB) do { L = vtr(lds + vs_ + vq##DB + (16 * (S2)) * 256); H = vtr(lds + vs_ + vq##DB + (16 * (S2) + 8) * 256); } while (0)
#define BB_PVM(PF, DB, L, H, A0, A1) do { o[DB] = MFMA32(((bf16x8){L[0], L[1], L[2], L[3], H[0], H[1], H[2], H[3]}), __builtin_bit_cast(bf16x8, PF), o[DB]); sacc_ += (A0) + (A1); SBAR(); } while (0)
#define BB_PVALL(C0, C1) do { s16x4 la_, ha_, lb_, hb_, lc_, hc_; u32x4 pf_; \
        BB_VRD(la_, ha_, 0, 0); BB_VRD(lb_, hb_, 0, 1); \
        pf_ = BB_PACK(C0, 0); BB_VRD(lc_, hc_, 0, 2); BB_EXP2(C1, 0); BB_PVM(pf_, 0, la_, ha_, C0[0], C0[1]); \
        BB_VRD(la_, ha_, 0, 3); BB_EXP2(C1, 2); BB_PVM(pf_, 1, lb_, hb_, C0[2], C0[3]); \
        BB_VRD(lb_, hb_, 1, 0); BB_EXP2(C1, 4); BB_PVM(pf_, 2, lc_, hc_, C0[4], C0[5]); \
        BB_VRD(lc_, hc_, 1, 1); BB_EXP2(C1, 6); BB_PVM(pf_, 3, la_, ha_, C0[6], C0[7]); \
        pf_ = BB_PACK(C0, 8); BB_VRD(la_, ha_, 1, 2); BB_EXP2(C1, 8); BB_PVM(pf_, 0, lb_, hb_, C0[8], C0[9]); \
        BB_VRD(lb_, hb_, 1, 3); BB_EXP2(C1, 10); BB_PVM(pf_, 1, lc_, hc_, C0[10], C0[11]); \
        BB_VRD(lc_, hc_, 2, 0); BB_EXP2(C1, 12); BB_PVM(pf_, 2, la_, ha_, C0[12], C0[13]); \
        BB_VRD(la_, ha_, 2, 1); BB_EXP2(C1, 14); BB_PVM(pf_, 3, lb_, hb_, C0[14], C0[15]); \
        pf_ = BB_PACK(C1, 0); BB_VRD(lb_, hb_, 2, 2); BB_PVM(pf_, 0, lc_, hc_, C1[0], C1[1]); \
        BB_VRD(lc_, hc_, 2, 3); BB_PVM(pf_, 1, la_, ha_, C1[2], C1[3]); \
        BB_VRD(la_, ha_, 3, 0); BB_PVM(pf_, 2, lb_, hb_, C1[4], C1[5]); \
        BB_VRD(lb_, hb_, 3, 1); BB_PVM(pf_, 3, lc_, hc_, C1[6], C1[7]); \
        pf_ = BB_PACK(C1, 8); BB_VRD(lc_, hc_, 3, 2); BB_PVM(pf_, 0, la_, ha_, C1[8], C1[9]); \
        BB_VRD(la_, ha_, 3, 3); BB_PVM(pf_, 1, lb_, hb_, C1[10], C1[11]); \
        BB_PVM(pf_, 2, lc_, hc_, C1[12], C1[13]); \
        BB_PVM(pf_, 3, la_, ha_, C1[14], C1[15]); \
    } while (0)
#define BB_STEP(C0, C1, N0, N1, T) do { \
        const int t_ = (T); \
        if (t_ + 3 < NT) BB_DMAK(t_ + 3, sl0); \
        if (t_ + 2 < NT) BB_DMAV(t_ + 2, sl2); \
        if (t_ < NTw) { \
            if (t_ > 0) { \
                if (t_ == NTw - 1) BB_MASK(C0, C1, t_); \
                float rm_; BB_ROWMAX(C0, C1, rm_); \
                if (__any(rm_ > BB_THR)) { const float dl_ = fmaxf(rm_, 0.f); mhat += dl_; \
                    _Pragma("unroll") for (int i = 0; i < 16; ++i) { C0[i] -= dl_; C1[i] -= dl_; negm[i] = -mhat; } \
                    const float f_ = fexp2(-dl_); l_run *= f_; \
                    _Pragma("unroll") for (int db = 0; db < 4; ++db) _Pragma("unroll") for (int i = 0; i < 16; ++i) o[db][i] *= f_; } \
            } \
            if (t_ + 1 < NTw) { \
                const int ks_ = sl1 * BB_SLOT; \
                bf16x8 fa_ = BB_KRD(kq0, 0), fb_ = BB_KRD(kq0, 32), fc_ = BB_KRD(kq1, 0); \
                SBAR(); \
                N0 = MFMA32(fa_, qf[0], negm); BB_EXP2(C0, 0);  fa_ = BB_KRD(kq1, 32); SBAR(); \
                N1 = MFMA32(fb_, qf[0], negm); BB_EXP2(C0, 2);  fb_ = BB_KRD(kq2, 0); SBAR(); \
                N0 = MFMA32(fc_, qf[1], N0);   BB_EXP2(C0, 4);  fc_ = BB_KRD(kq2, 32); SBAR(); \
                N1 = MFMA32(fa_, qf[1], N1);   BB_EXP2(C0, 6);  fa_ = BB_KRD(kq3, 0); SBAR(); \
                N0 = MFMA32(fb_, qf[2], N0);   BB_EXP2(C0, 8);  fb_ = BB_KRD(kq3, 32); SBAR(); \
                N1 = MFMA32(fc_, qf[2], N1);   BB_EXP2(C0, 10); SBAR(); \
                N0 = MFMA32(fa_, qf[3], N0);   BB_EXP2(C0, 12); SBAR(); \
                N1 = MFMA32(fb_, qf[3], N1);   BB_EXP2(C0, 14); SBAR(); \
            } else { \
                _Pragma("unroll") for (int i = 0; i < 16; ++i) C0[i] = fexp2(C0[i]); \
            } \
            const int vs_ = sl0 * BB_SLOT; float sacc_ = 0.f; \
            BB_PVALL(C0, C1); \
            l_run += sacc_; \
        } \
          \
        if (t_ + 3 < NT) BB_WAITBAR(4); else if (t_ + 2 < NT) BB_WAITBAR(2); else BB_WAITBAR(0); \
        { const int s_ = sl0; sl0 = sl1; sl1 = sl2; sl2 = s_; } \
    } while (0)
    int sl0 = 0, sl1 = 1, sl2 = 2;
    BB_DMAK(0, 0); BB_DMAV(0, 0); BB_DMAK(1, 1); BB_DMAV(1, 1); if (NT > 2) BB_DMAK(2, 2);
    BB_WAITBAR(0);
    f32x16 pA0, pA1, pB0, pB1;
    {
        const int ks_ = 0;
#pragma unroll
        for (int i = 0; i < 16; ++i) { pA0[i] = 0.f; pA1[i] = 0.f; pB0[i] = 0.f; pB1[i] = 0.f; }
        pA0 = MFMA32(BB_KRD(kq0, 0), qf[0], pA0); pA1 = MFMA32(BB_KRD(kq0, 32), qf[0], pA1);
        pA0 = MFMA32(BB_KRD(kq1, 0), qf[1], pA0); pA1 = MFMA32(BB_KRD(kq1, 32), qf[1], pA1);
        pA0 = MFMA32(BB_KRD(kq2, 0), qf[2], pA0); pA1 = MFMA32(BB_KRD(kq2, 32), qf[2], pA1);
        pA0 = MFMA32(BB_KRD(kq3, 0), qf[3], pA0); pA1 = MFMA32(BB_KRD(kq3, 32), qf[3], pA1);
        if (NTw == 1) BB_MASK(pA0, pA1, 0);
        float rm; BB_ROWMAX(pA0, pA1, rm);
        mhat = rm;
#pragma unroll
        for (int i = 0; i < 16; ++i) { pA0[i] -= rm; pA1[i] -= rm; negm[i] = -rm; }
    }
    BB_WAITBAR(0);
#pragma unroll 1
    for (int t = 0; t < NT; t += 2) {
        BB_STEP(pA0, pA1, pB0, pB1, t);
        BB_STEP(pB0, pB1, pA0, pA1, t + 1);
    }
#undef BB_DMAK
#undef BB_DMAV
#undef BB_WAITBAR
#undef BB_MASK
#undef BB_ROWMAX
#undef BB_EXP4
#undef BB_EXP2
#undef BB_PACK
#undef BB_KRD
#undef BB_VRD
#undef BB_PVM
#undef BB_PVALL
#undef BB_STEP
    const float l_tot = l_run + __shfl_xor(l_run, 32);
    const float inv = 1.0f / l_tot;
    LAS float* ex = (LAS float*)lds + wq * 4096;
    if (strm == 1) {
#pragma unroll
        for (int db = 0; db < 4; ++db)
#pragma unroll
            for (int i = 0; i < 16; ++i) ex[(db * 16 + i) * 64 + lane] = o[db][i] * inv;
    }
    __syncthreads();
    if (strm == 0) {
        float ss = 0.f;
#pragma unroll
        for (int db = 0; db < 4; ++db) {
#pragma unroll
            for (int i = 0; i < 16; ++i) { const float d = o[db][i] * inv - lam * ex[(db * 16 + i) * 64 + lane]; o[db][i] = d; ss += d * d; }
            __builtin_amdgcn_sched_barrier(0); }
        ss += __shfl_xor(ss, 32);
        const float rn = (1.0f / sqrtf(ss * (1.0f / 128.0f) + EPS)) * oscale;
        char* Zb = (char*)(Z + (rowbase + q0) * DM + h * 128);
        asm volatile("" : "+s"(subln));
        unsigned zoff = (unsigned)(q * DM + 4 * hh) * 2u; asm volatile("" : "+v"(zoff));
#pragma unroll
        for (int db = 0; db < 4; ++db)
#pragma unroll
            for (int i4 = 0; i4 < 4; ++i4) {
                const int d0 = 32 * db + 8 * i4 + 4 * hh;
                const u32x2 zz = *(const u32x2*)(Zb + (32 * db + 8 * i4) * 2 + zoff);
                const f32x4 sl = *(const f32x4*)(subln + d0);
                const float z0 = __uint_as_float(zz.x << 16), z1 = __uint_as_float(zz.x & 0xffff0000u), z2 = __uint_as_float(zz.y << 16), z3 = __uint_as_float(zz.y & 0xffff0000u);
                u32x2 w; w.x = cvtpk(o[db][4 * i4] * rn * sl.x * silu(z0), o[db][4 * i4 + 1] * rn * sl.y * silu(z1));
                w.y = cvtpk(o[db][4 * i4 + 2] * rn * sl.z * silu(z2), o[db][4 * i4 + 3] * rn * sl.w * silu(z3));
                if (!dry) *(u32x2*)(Zb + (32 * db + 8 * i4) * 2 + zoff) = w;
                __builtin_amdgcn_sched_barrier(0);
            }
    }
    __syncthreads();
}

DI void phase_attnB(const Params& p, LAS unsigned char* lds, int j, int layer, int tid, int wid, int lane, bool dry) {
    const bf16_t* Q = (const bf16_t*)(p.ws + WS_QKV); const bf16_t* K = Q + (size_t)MROWS * DM; const bf16_t* V = K + (size_t)MROWS * DM;
    bf16_t* Z = (bf16_t*)(p.ws + WS_Z);
    const float* lp = p.b_lambda + j * 256;
    const float d1 = wave_sum(lp[lane] * lp[64 + lane]), d2 = wave_sum(lp[128 + lane] * lp[192 + lane]);
    asm volatile("" : "+s"(layer));
    const float lam_init = (layer == 1) ? 0.35550906759096926f : 0.5560582041556006f;
    const float lam = expf(d1) - expf(d2) + lam_init;
    const float oscale = 1.0f - lam_init;
    const float* subln = p.b_subln + j * 128;
    const int G8 = gridDim.x >> 3;
    for (int v0 = blockIdx.x; v0 < 256; v0 += gridDim.x) {
        const int v = ((gridDim.x & 7) == 0) ? (v0 & 7) * G8 + (v0 >> 3) : v0;
        const int bh = v >> 4, s = v & 15;
#pragma unroll 1
        for (int k = 0; k < 4; ++k) {
            const int qb = (k == 0) ? 63 - s : (k == 1) ? 32 + s : (k == 2) ? 31 - s : s;
            attnB_unit((LAS char*)lds, Q, K, V, Z, subln, bh >> 3, bh & 7, qb, lam, oscale, tid, wid, lane, dry);
        }
    }
}

DI void phase_final(const Params& p, int wid, int lane) {
    const int gw = blockIdx.x * NWAVES + wid, NGW = gridDim.x * NWAVES;
    for (int m = gw; m < MROWS; m += NGW) {
        f32x4* xr = (f32x4*)(p.out + (size_t)m * DM) + lane; const f32x4* gr = (const f32x4*)p.final_norm + lane;
        f32x4 v[4]; float s = 0.f;
#pragma unroll
        for (int j = 0; j < 4; ++j) { v[j] = xr[64 * j]; s += (v[j].x * v[j].x + v[j].y * v[j].y) + (v[j].z * v[j].z + v[j].w * v[j].w); }
        const float rs = 1.0f / sqrtf(wave_sum(s) * (1.0f / DM) + EPS);
#pragma unroll
        for (int j = 0; j < 4; ++j) xr[64 * j] = v[j] * rs * gr[64 * j];
    }
}

#define XB_TMO      128
#define XB_XCNT(j)  (256  + 64 * (j))
#define XB_XSUB(j)  (1280 + 64 * (j))
#define XB_XGEN(j)  (2304 + 64 * (j))
#define XB_TOP      3328
#define XB_TOPGEN   3392
#define XCD_BAR_WORDS 3456
#define XB_SPIN_CAP (1u << 18)

__device__ __forceinline__ unsigned xb_ld(unsigned* p)              { return __hip_atomic_load(p, __ATOMIC_RELAXED, __HIP_MEMORY_SCOPE_AGENT); }
__device__ __forceinline__ unsigned xb_add(unsigned* p, unsigned v) { return __hip_atomic_fetch_add(p, v, __ATOMIC_RELAXED, __HIP_MEMORY_SCOPE_AGENT); }
__device__ __forceinline__ unsigned xb_xcc_id() { return (unsigned)__builtin_amdgcn_s_getreg((3 << 11) | 20) & 0xFu; }
#define XB_SPIN(cond, bar) do { unsigned _sp = 0; while (cond) { __builtin_amdgcn_s_sleep(1); \
    if ((++_sp & 255u) == 0u) { if (xb_ld(&(bar)[XB_TMO])) break; if (_sp > XB_SPIN_CAP) { atomicAdd(&(bar)[XB_TMO], 1u); break; } } } } while (0)

struct XcdBarrier {
    unsigned* bar; unsigned x;
    volatile LAS unsigned* st;
};

__device__ __forceinline__ XcdBarrier xcd_barrier_post(unsigned* bar, volatile LAS unsigned* st) {
    XcdBarrier b; b.bar = bar; b.x = xb_xcc_id(); b.st = st;
    if (threadIdx.x == 0) (void)xb_add(&bar[XB_XCNT(b.x)], 1u);
    return b;
}
__device__ __forceinline__ void xcd_barrier_complete(unsigned* bar, unsigned x, unsigned& nloc, unsigned& nx) {
    const unsigned G = gridDim.x * gridDim.y * gridDim.z;
    unsigned sum, cnt, mine, sp = 0u;
    for (;;) {
        sum = 0u; cnt = 0u; mine = 0u;
#pragma unroll
        for (unsigned j = 0; j < 16; ++j) { const unsigned c = xb_ld(&bar[XB_XCNT(j)]); sum += c; cnt += (c > 0u) ? 1u : 0u; mine = (j == x) ? c : mine; }
        if (sum == G) break;
        __builtin_amdgcn_s_sleep(1);
        if ((++sp & 255u) == 0u) { if (xb_ld(&bar[XB_TMO])) break; if (sp > XB_SPIN_CAP) { atomicAdd(&bar[XB_TMO], 1u); break; } }
    }
    nloc = mine > 0u ? mine : 1u; nx = cnt > 0u ? cnt : 1u;
}

__device__ __forceinline__ void xcd_barrier(const XcdBarrier& b) {
    asm volatile("s_waitcnt vmcnt(0)" ::: "memory");
    __syncthreads();
    if (threadIdx.x == 0) {
        unsigned* bar = b.bar;
        __builtin_amdgcn_s_waitcnt(0);
        unsigned nloc = b.st[0], nx = b.st[1];
        if (nloc == 0u) { xcd_barrier_complete(bar, b.x, nloc, nx); b.st[0] = nloc; b.st[1] = nx; }
        const unsigned old = xb_add(&bar[XB_XSUB(b.x)], 1u);
        const unsigned gen = old / nloc;
        if (old + 1u == (gen + 1u) * nloc) {
            __builtin_amdgcn_fence(__ATOMIC_RELEASE, "agent");
            asm volatile("s_waitcnt vmcnt(0)" ::: "memory");
            const unsigned og = xb_add(&bar[XB_TOP], 1u);
            const unsigned tg = og / nx;
            if (og + 1u == (tg + 1u) * nx) xb_add(&bar[XB_TOPGEN], 1u);
            else XB_SPIN(xb_ld(&bar[XB_TOPGEN]) == tg, bar);
            __builtin_amdgcn_fence(__ATOMIC_ACQUIRE, "agent");
            xb_add(&bar[XB_XGEN(b.x)], 1u);
            asm volatile("s_waitcnt vmcnt(0)" ::: "memory");
        } else {
            XB_SPIN(xb_ld(&bar[XB_XGEN(b.x)]) == gen, bar);
            __builtin_amdgcn_fence(__ATOMIC_ACQUIRE, "agent");
            asm volatile("s_waitcnt vmcnt(0)" ::: "memory");
        }
    }
    __syncthreads();
}

#ifndef PROBE_KIND
#define PROBE_KIND -1
#endif
__global__ void __launch_bounds__(NTHREADS, 2) fwd_megakernel(Params p_arg) {
    extern __shared__ __attribute__((aligned(16))) unsigned char lds_raw[];
    LAS unsigned char* lds = (LAS unsigned char*)lds_raw;
    cg::grid_group grid = cg::this_grid();
    const int lo = p_arg.ph_lo, hi = p_arg.ph_hi;
    volatile LAS unsigned* bst = (volatile LAS unsigned*)(lds + LDS_BYTES - 64);
    unsigned* barw = (unsigned*)(p_arg.ws + WS_BAR);
    if (threadIdx.x == 0) { bst[0] = 0u; bst[1] = 0u; }
    if (blockIdx.x == 0) for (int i = threadIdx.x; i < XCD_BAR_WORDS; i += NTHREADS) barw[i] = 0u;
    __syncthreads();
    XcdBarrier xb; xb.bar = barw; xb.x = 0; xb.st = bst;
#pragma unroll 1
    for (int ph = lo; ph < hi; ++ph) {
        int kind;
        if (ph == 0) kind = 0; else if (ph == 21) kind = 7; else { const int r_ = (ph - 1) % 10; kind = (r_ < 6) ? 1 + r_ % 3 : (r_ == 7) ? 4 : (r_ == 8) ? 5 : 6; }
        const int reps = (kind == PROBE_KIND) ? 2 : 1;
#pragma unroll 1
        for (int rep = 0; rep < reps; ++rep) {
        int tid = threadIdx.x; asm volatile("" : "+v"(tid));
#if defined(__HIP_DEVICE_COMPILE__)
        const __attribute__((address_space(4))) Params* pp = (const __attribute__((address_space(4))) Params*)__builtin_amdgcn_kernarg_segment_ptr();
        asm volatile("" : "+s"(pp));
        const Params p = *pp;
#else
        const Params p = p_arg;
#endif
        const int lane = tid & 63, wid = __builtin_amdgcn_readfirstlane(tid >> 6);
        unsigned char* ws = p.ws;
        bf16_t* XG = (bf16_t*)(ws + WS_XG); bf16_t* Zb = (bf16_t*)(ws + WS_Z); bf16_t* QKV = (bf16_t*)(ws + WS_QKV);
        float* SSQ = (float*)(ws + WS_SSQ);
        const float* cosA = (const float*)(ws + WS_ROPE); const float* sinA = cosA + SEQ * 16; const float* cosB = sinA + SEQ * 16; const float* sinB = cosB + SEQ * 8;
        const bool dry = (PROBE_KIND >= 0) && (rep + 1 < reps) && (p.ph_hi < 1000);
        if (ph == 0) phase_prologue(p, lds, tid, wid, lane);
        else if (ph == 21) phase_final(p, wid, lane);
        else {
            const int k = ph - 1, pair = k / 10, r = k % 10;
            if (r < 6) {
                const int bidx = r / 3, s = r % 3;
                if (s == 0) {
                    pg8::Gemm g{XG + (size_t)bidx * SEQ * DM, (const bf16_t*)(ws + WS_WA_IN) + (size_t)pair * 10240 * 1024, SEQ, 10240, DM};
                    pg8::StaticOrder S; S.init(SEQ, 10240, gridDim.x, blockIdx.x);
                    EpiInA E{QKV, Zb + (size_t)bidx * SEQ * DM, SSQ + (size_t)bidx * SEQ * 16, cosA, sinA, 0.08838834764831845f * LOG2E};
                    pg8::gemm_phase<EpiInA, pg8::StaticOrder, true, true>(lds, g, S, E, tid);
                } else if (s == 1) phase_attnA(p, lds, wid, lane, dry);
                else phase_combineA(p, bidx, tid);
            } else if (r == 7) {
                pg8::Gemm g{XG, (const bf16_t*)(ws + WS_WB_IN) + (size_t)pair * 4096 * 1024, MROWS, 4096, DM};
                pg8::StaticOrder S; S.init(MROWS, 4096, gridDim.x, blockIdx.x);
                EpiInB E{QKV, Zb, SSQ, cosB, sinB, 0.125f * LOG2E};
                pg8::gemm_phase<EpiInB, pg8::StaticOrder, true, true>(lds, g, S, E, tid);
            } else if (r == 8) phase_attnB(p, lds, pair, 2 * pair + 1, tid, wid, lane, dry);
            else {
                const bool isA = (r == 6);
                const int layer = 2 * pair + (isA ? 0 : 1);
                const bf16_t* Wt = (const bf16_t*)(ws + (isA ? WS_WA_OUT : WS_WB_OUT)) + (size_t)pair * 1024 * 1024;
                const float* gnext = isA ? p.b_norm + pair * DM : (layer == 3 ? (const float*)nullptr : p.a_norm + (pair + 1) * DM);
                pg8::Gemm g{Zb, Wt, MROWS, DM, DM};
                pg8::StaticOrder S; S.init(MROWS, DM, gridDim.x, blockIdx.x);
                EpiOut E{(layer == 0) ? p.x : (const float*)p.out, p.out, XG, gnext, SSQ};
                pg8::gemm_phase<EpiOut, pg8::StaticOrder, true, true>(lds, g, S, E, tid);
            }
        }
        }
        if (ph + 1 < hi) { if (ph == lo) { grid.sync(); xb = xcd_barrier_post(barw, bst); } else xcd_barrier(xb); }
    }
}

constexpr int N_PHASES = 22;
#ifndef MK_PER_PHASE
#define MK_PER_PHASE 0
#endif

extern "C" void kernel_launch(void* const* d_in, const int* in_sizes, int n_in, void* d_out, int out_size, void* d_ws, size_t ws_size, hipStream_t stream) {
    static int grid = 0;
    if (grid == 0) {
        int dev = 0, cus = 0, per_cu = 0;
        hipGetDevice(&dev);
        hipDeviceGetAttribute(&cus, hipDeviceAttributeMultiprocessorCount, dev);
        hipFuncSetAttribute((const void*)fwd_megakernel, hipFuncAttributeMaxDynamicSharedMemorySize, LDS_BYTES);
        hipOccupancyMaxActiveBlocksPerMultiprocessor(&per_cu, (const void*)fwd_megakernel, NTHREADS, LDS_BYTES);
        if (per_cu < 1) { fprintf(stderr, "kernel_launch: occupancy query says %d blocks per CU\n", per_cu); per_cu = 1; }
        (void)hipGetLastError();
        grid = cus * 1;
        if (ws_size < WS_END) { fprintf(stderr, "kernel_launch: workspace too small (%zu < %zu)\n", ws_size, (size_t)WS_END); grid = -1; }
    }
    if (grid < 0) return;
    Params p{};
    p.x = (const float*)d_in[0]; p.a_norm = (const float*)d_in[1]; p.a_w_in = (const float*)d_in[2]; p.a_w_out = (const float*)d_in[3];
    p.b_norm = (const float*)d_in[4]; p.b_w_in = (const float*)d_in[5]; p.b_lambda = (const float*)d_in[6]; p.b_subln = (const float*)d_in[7];
    p.b_w_out = (const float*)d_in[8]; p.final_norm = (const float*)d_in[9];
    p.out = (float*)d_out; p.ws = (unsigned char*)d_ws;
#if MK_PER_PHASE
    for (int ph = 0; ph < N_PHASES; ++ph) {
        p.ph_lo = ph; p.ph_hi = ph + 1;
        hipLaunchKernelGGL(fwd_megakernel, dim3(grid), dim3(NTHREADS), LDS_BYTES, stream, p);
    }
#else
    p.ph_lo = 0; p.ph_hi = N_PHASES;
    void* args[] = {&p};
    hipError_t e = hipLaunchCooperativeKernel((const void*)fwd_megakernel, dim3(grid), dim3(NTHREADS), args, LDS_BYTES, stream);
    if (e != hipSuccess) fprintf(stderr, "cooperative launch failed: %s (grid %d)\n", hipGetErrorString(e), grid);
#endif
}
```

```cpp
#include <hip/hip_runtime.h>
#include <hip/hip_cooperative_groups.h>
#include <cstdio>
#include <cstdint>
namespace cg = cooperative_groups;
namespace pg8 {
#define PG8_LAS __attribute__((address_space(3)))
typedef unsigned short bf16_t;
typedef short bf16x8 __attribute__((ext_vector_type(8)));
typedef float f32x4 __attribute__((ext_vector_type(4)));
typedef unsigned u32x4 __attribute__((ext_vector_type(4)));
constexpr int BM = 256, BK = 64, HALF = 128, HTB = HALF * BK * 2  , STAGE_BYTES = 8 * HTB, NXCD = 8, WGM = 8;

__host__ __device__ __forceinline__ int lds_byte(int r, int c) { const int st = (r >> 4) * 2 + (c >> 5), rr = r & 15, cc = c & 31, ob = rr * 64 + cc * 2; return st * 1024 + (ob ^ (((ob >> 9) & 1) << 5)); }
__host__ __device__ __forceinline__ void stage_rc(int b, int& R, int& C) { const int st = b / 1024, sb = b % 1024, swz = sb ^ (((sb >> 9) & 1) << 5); R = (st >> 1) * 16 + swz / 64; C = (st & 1) * 32 + (swz % 64) / 2; }
__host__ __device__ __forceinline__ int perm32(int rho) { const int n = rho >> 4, i = rho & 15; return 8 * (i >> 2) + 4 * n + (i & 3); }

struct Unit { int pm, pn; };
struct Gemm { const bf16_t* A; const bf16_t* Bt; int M, N, K; };

struct StaticOrder {
    int nM, nN, nwg, G, c;
    __host__ __device__ void init(int M, int N, int G_, int c_) { nM = M / BM; nN = N / BM; nwg = nM * nN; G = G_; c = c_; }
    __host__ __device__ bool next(int i, Unit& u) const {
        const long L = (long)i * G + c; if (L >= nwg) return false;
        int wgid = (int)L; { const int q = nwg / NXCD, r = nwg % NXCD, xcd = wgid % NXCD, off = wgid / NXCD; wgid = (xcd < r ? xcd * (q + 1) : r * (q + 1) + (xcd - r) * q) + off; }
        const int nig = WGM * nN, gid = wgid / nig, fm = gid * WGM, gsz = (nM - fm) < WGM ? (nM - fm) : WGM;
        u.pm = fm + ((wgid % nig) % gsz); u.pn = (wgid % nig) / gsz; return true;
    }
    __device__ __forceinline__ void a_ready(const Unit&) const {}
    __device__ __forceinline__ void done(const Unit&) const {}
};

__device__ __forceinline__ unsigned cvt_pk_bf16(float lo, float hi) { unsigned r; asm volatile("v_cvt_pk_bf16_f32 %0, %1, %2" : "=v"(r) : "v"(lo), "v"(hi)); return r; }
typedef float f32x2 __attribute__((ext_vector_type(2)));
template <class Epi, class Sched, bool ALIGN_EPI = false, bool SP2 = false>
__device__ __forceinline__ void gemm_phase(PG8_LAS unsigned char* lds, const Gemm g, const Sched& S, const Epi& E, const int tid) {
    const int wid = __builtin_amdgcn_readfirstlane(tid >> 6), lane = tid & 63, wr = wid >> 2, wc = wid & 3, fr = lane & 15, fq = lane >> 4;
    const int K = g.K, nt = K / BK;
    unsigned voffA[2], voffB[2];
#pragma unroll
    for (int i = 0; i < 2; ++i) { int R, C; stage_rc(tid * 16 + i * 8192, R, C); const int Rb = Epi::PERM ? ((R & ~31) + perm32(R & 31)) : R;
        voffA[i] = (unsigned)(R * K + C) * 2u; voffB[i] = (unsigned)(Rb * K + C) * 2u; }
    const size_t kstep = (size_t)(BK * 2);
    const size_t hstep = (size_t)HALF * K * 2;
    const size_t tstep = 2 * hstep;
    const unsigned ldsw = (unsigned)wid * 1024u;
    const int aoff = lds_byte(wr * 64 + fr, fq * 8), boff = lds_byte(wc * 32 + fr, fq * 8);
#define PG8_SA(b, h) (((b) * 2 + (h)) * HTB)
#define PG8_SB(b, h) ((4 + (b) * 2 + (h)) * HTB)
#define PG8_STAGE(bufoff, gbase, voff) do { _Pragma("unroll") for (int _i = 0; _i < 2; ++_i) \
        __builtin_amdgcn_global_load_lds((const unsigned*)((const char*)(gbase) + (voff)[_i]), (PG8_LAS unsigned*)(lds + (bufoff) + ldsw + _i * 8192), 16, 0, 0); } while (0)
#define PG8_LDA(dst, b, h) do { _Pragma("unroll") for (int m = 0; m < 4; ++m) _Pragma("unroll") for (int k = 0; k < 2; ++k) dst[m][k] = *(const PG8_LAS bf16x8*)(lds + PG8_SA(b, h) + aoff + m * 2048 + k * 1024); } while (0)
#define PG8_LDB(dst, b, h) do { _Pragma("unroll") for (int n = 0; n < 2; ++n) _Pragma("unroll") for (int k = 0; k < 2; ++k) dst[n][k] = *(const PG8_LAS bf16x8*)(lds + PG8_SB(b, h) + boff + n * 2048 + k * 1024); } while (0)
#define PG8_MMA(ai, bj, At, Bt) do { __builtin_amdgcn_s_setprio(1); _Pragma("unroll") for (int m = 0; m < 4; ++m) _Pragma("unroll") for (int n = 0; n < 2; ++n) _Pragma("unroll") for (int k = 0; k < 2; ++k) \
        acc[ai][bj][m][n] = __builtin_amdgcn_mfma_f32_16x16x32_bf16(Bt[n][k], At[m][k], acc[ai][bj][m][n], 0, 0, 0); __builtin_amdgcn_s_setprio(0); } while (0)
#define PG8_WAIT_V(n) asm volatile("s_waitcnt vmcnt(" #n ")" ::: "memory")
#define PG8_WAIT_L(n) asm volatile("s_waitcnt lgkmcnt(" #n ")" ::: "memory")
#define PG8_BAR __builtin_amdgcn_s_barrier()
#define PG8_SCHED __builtin_amdgcn_sched_barrier(0)
    Unit cur, nxt; int ui = 0;
    if (!S.next(0, cur)) return;
    f32x4 acc[2][2][4][2];
#pragma unroll
    for (int a = 0; a < 2; ++a)
#pragma unroll
        for (int b = 0; b < 2; ++b)
#pragma unroll
            for (int m = 0; m < 4; ++m)
#pragma unroll
                for (int n = 0; n < 2; ++n) acc[a][b][m][n] = (f32x4){0.f, 0.f, 0.f, 0.f};
    bf16x8 At[4][2], B0[2][2], B1[2][2];
    const char* cA = (const char*)g.A + (size_t)cur.pm * tstep; const char* cB = (const char*)g.Bt + (size_t)cur.pn * tstep;
    S.a_ready(cur);
    if constexpr (SP2) {
        PG8_STAGE(PG8_SB(0, 0), cB, voffB); PG8_STAGE(PG8_SB(0, 1), cB + hstep, voffB); PG8_STAGE(PG8_SA(0, 0), cA, voffA); PG8_STAGE(PG8_SA(0, 1), cA + hstep, voffA);
        if (wr == 1) PG8_BAR;
        PG8_WAIT_V(2); PG8_BAR;
        PG8_STAGE(PG8_SB(1, 0), cB + kstep, voffB); PG8_STAGE(PG8_SA(1, 0), cA + kstep, voffA); PG8_STAGE(PG8_SB(1, 1), cB + hstep + kstep, voffB);
        PG8_WAIT_V(6); PG8_BAR;
    } else {
        PG8_STAGE(PG8_SB(0, 0), cB, voffB); PG8_STAGE(PG8_SA(0, 0), cA, voffA); PG8_STAGE(PG8_SB(0, 1), cB + hstep, voffB); PG8_STAGE(PG8_SA(0, 1), cA + hstep, voffA);
        if (wr == 1) PG8_BAR;
        PG8_WAIT_V(4); PG8_BAR;
        PG8_STAGE(PG8_SB(1, 0), cB + kstep, voffB); PG8_STAGE(PG8_SA(1, 0), cA + kstep, voffA); PG8_STAGE(PG8_SB(1, 1), cB + hstep + kstep, voffB);
        PG8_WAIT_V(6); PG8_BAR;
    }
    for (;;) {
        const bool has_next = S.next(ui + 1, nxt);
        const char* nA = has_next ? (const char*)g.A + (size_t)nxt.pm * tstep : cA; const char* nB = has_next ? (const char*)g.Bt + (size_t)nxt.pn * tstep : cB;
        for (int t = 0; t < nt; t += 2) {
            const bool last = (t == nt - 2);
            const char* a1 = cA + (size_t)(t + 1) * kstep;
            const char* a2 = last ? nA : cA + (size_t)(t + 2) * kstep; const char* b2 = last ? nB : cB + (size_t)(t + 2) * kstep;
            const char* a3 = a2 + kstep; const char* b3 = b2 + kstep;
            if (last && has_next) S.a_ready(nxt);
            if constexpr (SP2) {
            PG8_LDB(B0, 0, 0); PG8_LDB(B1, 0, 1); PG8_SCHED; PG8_LDA(At, 0, 0); PG8_STAGE(PG8_SA(1, 1), a1 + hstep, voffA);
            PG8_WAIT_V(8); PG8_WAIT_L(0); PG8_BAR; PG8_MMA(0, 0, At, B0); PG8_MMA(0, 1, At, B1); PG8_BAR; PG8_SCHED;
            PG8_LDA(At, 0, 1); PG8_STAGE(PG8_SB(0, 0), b2, voffB); PG8_STAGE(PG8_SB(0, 1), b2 + hstep, voffB); PG8_STAGE(PG8_SA(0, 0), a2, voffA);
            PG8_WAIT_V(8); PG8_WAIT_L(0); PG8_BAR; PG8_MMA(1, 0, At, B0); PG8_MMA(1, 1, At, B1); PG8_BAR; PG8_SCHED;
            PG8_LDB(B0, 1, 0); PG8_LDB(B1, 1, 1); PG8_SCHED; PG8_LDA(At, 1, 0); PG8_STAGE(PG8_SA(0, 1), a2 + hstep, voffA);
            PG8_WAIT_V(8); PG8_WAIT_L(0); PG8_BAR; PG8_MMA(0, 0, At, B0); PG8_MMA(0, 1, At, B1); PG8_BAR; PG8_SCHED;
            PG8_LDA(At, 1, 1); PG8_STAGE(PG8_SB(1, 0), b3, voffB); PG8_STAGE(PG8_SB(1, 1), b3 + hstep, voffB); PG8_STAGE(PG8_SA(1, 0), a3, voffA);
            PG8_WAIT_V(8); PG8_WAIT_L(0); PG8_BAR; PG8_MMA(1, 0, At, B0); PG8_MMA(1, 1, At, B1); PG8_BAR; PG8_SCHED;
            } else {
            PG8_LDB(B0, 0, 0); PG8_SCHED; PG8_LDA(At, 0, 0); PG8_STAGE(PG8_SA(1, 1), a1 + hstep, voffA);
            PG8_WAIT_L(8); PG8_BAR; PG8_WAIT_L(0); PG8_MMA(0, 0, At, B0); PG8_BAR; PG8_SCHED;
            PG8_LDB(B1, 0, 1); PG8_STAGE(PG8_SB(0, 0), b2, voffB);
            PG8_BAR; PG8_WAIT_L(0); PG8_MMA(0, 1, At, B1); PG8_BAR;
            PG8_LDA(At, 0, 1); PG8_STAGE(PG8_SA(0, 0), a2, voffA);
            PG8_BAR; PG8_WAIT_L(0); PG8_MMA(1, 0, At, B0); PG8_BAR; PG8_SCHED;
            PG8_STAGE(PG8_SB(0, 1), b2 + hstep, voffB);
            PG8_WAIT_V(6); PG8_BAR; PG8_MMA(1, 1, At, B1); PG8_BAR;
            PG8_LDB(B0, 1, 0); PG8_SCHED; PG8_LDA(At, 1, 0); PG8_STAGE(PG8_SA(0, 1), a2 + hstep, voffA);
            PG8_WAIT_L(8); PG8_BAR; PG8_WAIT_L(0); PG8_MMA(0, 0, At, B0); PG8_BAR; PG8_SCHED;
            PG8_LDB(B1, 1, 1); PG8_STAGE(PG8_SB(1, 0), b3, voffB);
            PG8_BAR; PG8_WAIT_L(0); PG8_MMA(0, 1, At, B1); PG8_BAR;
            PG8_LDA(At, 1, 1); PG8_STAGE(PG8_SA(1, 0), a3, voffA);
            PG8_BAR; PG8_WAIT_L(0); PG8_MMA(1, 0, At, B0); PG8_BAR; PG8_SCHED;
            PG8_STAGE(PG8_SB(1, 1), b3 + hstep, voffB);
            PG8_WAIT_V(6); PG8_BAR; PG8_MMA(1, 1, At, B1); PG8_BAR;
            }
        }
        if constexpr (ALIGN_EPI) { if (wr == 0) PG8_BAR; }
        if constexpr (!Epi::AFTER_DRAIN) { E(acc, cur, wr, wc, fr, fq); S.done(cur); }
        if (!has_next) break;
#pragma unroll
        for (int a = 0; a < 2; ++a)
#pragma unroll
            for (int b = 0; b < 2; ++b)
#pragma unroll
                for (int m = 0; m < 4; ++m)
#pragma unroll
                    for (int n = 0; n < 2; ++n) acc[a][b][m][n] = (f32x4){0.f, 0.f, 0.f, 0.f};
        cur = nxt; cA = nA; cB = nB; ++ui;
        if constexpr (ALIGN_EPI) { if (wr == 1) PG8_BAR; }
    }
    PG8_WAIT_V(0);
    if constexpr (!ALIGN_EPI) { if (wr == 0) PG8_BAR; }
    PG8_BAR;
    if constexpr (Epi::AFTER_DRAIN) { E.fused(acc, cur, wr, wc, fr, fq, lds, wid, lane); S.done(cur); }
#undef PG8_SA
#undef PG8_SB
#undef PG8_STAGE
#undef PG8_LDA
#undef PG8_LDB
#undef PG8_MMA
#undef PG8_WAIT_V
#undef PG8_WAIT_L
#undef PG8_BAR
#undef PG8_SCHED
}
}

#define DI __device__ __forceinline__
#define LAS __attribute__((address_space(3)))
typedef unsigned short bf16_t;
typedef short bf16x8 __attribute__((ext_vector_type(8)));
typedef short s16x4 __attribute__((ext_vector_type(4)));
typedef float f32x4 __attribute__((ext_vector_type(4)));
typedef float f32x16 __attribute__((ext_vector_type(16)));
typedef unsigned u32x4 __attribute__((ext_vector_type(4)));
typedef unsigned u32x2 __attribute__((ext_vector_type(2)));
typedef float f32x2_t __attribute__((ext_vector_type(2)));
typedef __bf16 bf16x2_t __attribute__((ext_vector_type(2)));
typedef short v4i16_t __attribute__((ext_vector_type(4)));

constexpr int SEQ = 8192, DM = 1024, MROWS = 16384;
constexpr int NWAVES = 8, NTHREADS = 512;
constexpr int LDS_BYTES = 155648;
constexpr float EPS = 1e-6f;
constexpr float LOG2E = 1.4426950408889634f, LN2 = 0.6931471805599453f;
constexpr float NEGB = -1e30f;

constexpr size_t MiB = 1u << 20;
constexpr size_t WS_WA_IN = 0, WS_WB_IN = 40 * MiB, WS_WA_OUT = 56 * MiB, WS_WB_OUT = 60 * MiB;
constexpr size_t WS_XG = 64 * MiB, WS_Z = 96 * MiB, WS_QKV = 128 * MiB;
constexpr size_t WS_SSQ = 272 * MiB, WS_LSE = 273 * MiB, WS_ROPE = 274 * MiB, WS_BAR = 276 * MiB, WS_END = 277 * MiB;

struct Params {
    const float* x; const float* a_norm; const float* a_w_in; const float* a_w_out;
    const float* b_norm; const float* b_w_in; const float* b_lambda; const float* b_subln; const float* b_w_out; const float* final_norm;
    float* out; unsigned char* ws; int ph_lo, ph_hi;
};

DI unsigned cvtpk(float lo, float hi) { f32x2_t v = {lo, hi}; bf16x2_t b = __builtin_convertvector(v, bf16x2_t); return __builtin_bit_cast(unsigned, b); }
DI float bf2f(unsigned short b) { return __uint_as_float(((unsigned)b) << 16); }
DI int crow(int r, int hi) { return (r & 3) + 8 * (r >> 2) + 4 * hi; }
DI s16x4 vtr(const LAS char* p) { return __builtin_bit_cast(s16x4, __builtin_amdgcn_ds_read_tr16_b64_v4i16((LAS v4i16_t*)p)); }
DI float fexp2(float x) { return __builtin_amdgcn_exp2f(x); }
DI float silu(float z) { return z / (1.f + __expf(-z)); }
DI float wave_sum(float v) {
#pragma unroll
    for (int o = 1; o < 64; o <<= 1) v += __shfl_xor(v, o);
    return v;
}
DI float fadd_s(float a, float b) { float r; asm("v_add_f32_e32 %0, %1, %2" : "=v"(r) : "v"(a), "v"(b)); return r; }
DI float max3_s(float a, float b, float c) { float r; asm("v_max3_f32 %0, %1, %2, %3" : "=v"(r) : "v"(a), "v"(b), "v"(c)); return r; }
#define MFMA32(a, b, c) __builtin_amdgcn_mfma_f32_32x32x16_bf16((a), (b), (c), 0, 0, 0)

using pg8::Unit;
struct EpiInA {
    static constexpr bool PERM = true, AFTER_DRAIN = false;
    bf16_t* qkv; bf16_t* z; const float* ssq; const float* cs; const float* sn; float qscale;
    DI void operator()(const f32x4 (&acc)[2][2][4][2], const Unit& u, int wr, int wc, int fr, int fq) const {
        const int ct = u.pn; bf16_t* base; int kind;
        if (ct < 36) { const int g = ct / 12, t = (ct % 12) >> 2; kind = t; base = qkv + (size_t)(g * 3 + t) * ((size_t)SEQ * DM) + (ct & 3) * 256; }
        else { kind = 3; base = z + (ct - 36) * 256; }
        const bool rot = (kind < 2) && (wc == 0);
        const float osc = (kind == 0) ? qscale : 1.f;
#pragma unroll
        for (int ai = 0; ai < 2; ++ai)
#pragma unroll
            for (int m = 0; m < 4; ++m) {
                const int row = u.pm * 256 + ai * 128 + wr * 64 + m * 16 + fr;
                const f32x4* sp = (const f32x4*)(ssq + (size_t)row * 16);
                const f32x4 pa = sp[0], pb = sp[1], pc = sp[2], pd = sp[3];
                const float ss = (((pa.x + pa.y) + (pa.z + pa.w)) + ((pb.x + pb.y) + (pb.z + pb.w))) + (((pc.x + pc.y) + (pc.z + pc.w)) + ((pd.x + pd.y) + (pd.z + pd.w)));
                const float rs = 1.0f / sqrtf(ss * (1.0f / DM) + EPS);
                f32x4 c0 = {1.f, 1.f, 1.f, 1.f}, c1 = c0, s0 = {0.f, 0.f, 0.f, 0.f}, s1 = s0;
                if (rot) { const int ib = row * 16 + 8 * (fq & 1); c0 = *(const f32x4*)(cs + ib); c1 = *(const f32x4*)(cs + ib + 4); s0 = *(const f32x4*)(sn + ib); s1 = *(const f32x4*)(sn + ib + 4);
                           if (fq < 2) { s0 = -s0; s1 = -s1; } }
#pragma unroll
                for (int bj = 0; bj < 2; ++bj) {
                    f32x4 v0 = acc[ai][bj][m][0] * rs, v1 = acc[ai][bj][m][1] * rs;
                    if (rot) {
                        f32x4 p0, p1;
#pragma unroll
                        for (int j = 0; j < 4; ++j) { p0[j] = __shfl_xor(v0[j], 32); p1[j] = __shfl_xor(v1[j], 32); }
                        v0 = v0 * c0 + p0 * s0; v1 = v1 * c1 + p1 * s1;
                    }
                    v0 = v0 * osc; v1 = v1 * osc;
                    u32x4 w; w.x = cvtpk(v0[0], v0[1]); w.y = cvtpk(v0[2], v0[3]); w.z = cvtpk(v1[0], v1[1]); w.w = cvtpk(v1[2], v1[3]);
                    *(u32x4*)(base + (size_t)row * DM + bj * 128 + wc * 32 + 8 * fq) = w;
                }
            }
    }
};
struct EpiInB {
    static constexpr bool PERM = true, AFTER_DRAIN = false;
    bf16_t* qkv; bf16_t* z; const float* ssq; const float* cs; const float* sn; float qscale;
    DI void operator()(const f32x4 (&acc)[2][2][4][2], const Unit& u, int wr, int wc, int fr, int fq) const {
        const int ct = u.pn; const int kind = ct >> 2;
        bf16_t* base = (kind < 3 ? qkv + (size_t)kind * ((size_t)MROWS * DM) : z) + (ct & 3) * 256;
        const bool rot = (kind < 2) && ((wc & 1) == 0);
        const float osc = (kind == 0) ? qscale : 1.f;
#pragma unroll
        for (int ai = 0; ai < 2; ++ai)
#pragma unroll
            for (int m = 0; m < 4; ++m) {
                const int row = u.pm * 256 + ai * 128 + wr * 64 + m * 16 + fr;
                const f32x4* sp = (const f32x4*)(ssq + (size_t)row * 16);
                const f32x4 pa = sp[0], pb = sp[1], pc = sp[2], pd = sp[3];
                const float ss = (((pa.x + pa.y) + (pa.z + pa.w)) + ((pb.x + pb.y) + (pb.z + pb.w))) + (((pc.x + pc.y) + (pc.z + pc.w)) + ((pd.x + pd.y) + (pd.z + pd.w)));
                const float rs = 1.0f / sqrtf(ss * (1.0f / DM) + EPS);
                f32x4 c0 = {1.f, 1.f, 1.f, 1.f}, c1 = c0, s0 = {0.f, 0.f, 0.f, 0.f}, s1 = s0;
                if (rot && fq < 2) { const int ib = (row & (SEQ - 1)) * 8; c0 = *(const f32x4*)(cs + ib); c1 = *(const f32x4*)(cs + ib + 4); s0 = *(const f32x4*)(sn + ib); s1 = *(const f32x4*)(sn + ib + 4);
                                     if (fq == 0) { s0 = -s0; s1 = -s1; } }
#pragma unroll
                for (int bj = 0; bj < 2; ++bj) {
                    f32x4 v0 = acc[ai][bj][m][0] * rs, v1 = acc[ai][bj][m][1] * rs;
                    if (rot) {
                        f32x4 p0, p1;
#pragma unroll
                        for (int j = 0; j < 4; ++j) { p0[j] = __shfl_xor(v0[j], 16); p1[j] = __shfl_xor(v1[j], 16); }
                        v0 = v0 * c0 + p0 * s0; v1 = v1 * c1 + p1 * s1;
                    }
                    v0 = v0 * osc; v1 = v1 * osc;
                    u32x4 w; w.x = cvtpk(v0[0], v0[1]); w.y = cvtpk(v0[2], v0[3]); w.z = cvtpk(v1[0], v1[1]); w.w = cvtpk(v1[2], v1[3]);
                    *(u32x4*)(base + (size_t)row * DM + bj * 128 + wc * 32 + 8 * fq) = w;
                }
            }
    }
};
struct EpiOut {
    static constexpr bool PERM = false, AFTER_DRAIN = false;
    const float* xin; float* xout; bf16_t* xg; const float* gnext; float* ssq;
    DI void operator()(const f32x4 (&acc)[2][2][4][2], const Unit& u, int wr, int wc, int fr, int fq) const {
#pragma unroll
        for (int ai = 0; ai < 2; ++ai)
#pragma unroll
            for (int m = 0; m < 4; ++m) {
                const int row = u.pm * 256 + ai * 128 + wr * 64 + m * 16 + fr;
                float ss = 0.f;
#pragma unroll
                for (int bj = 0; bj < 2; ++bj)
#pragma unroll
                    for (int n = 0; n < 2; ++n) {
                        const int col = u.pn * 256 + bj * 128 + wc * 32 + n * 16 + 4 * fq;
                        const size_t off = (size_t)row * DM + col;
                        const f32x4 v = *(const f32x4*)(xin + off) + acc[ai][bj][m][n];
                        *(f32x4*)(xout + off) = v;
                        ss += (v.x * v.x + v.y * v.y) + (v.z * v.z + v.w * v.w);
                        if (gnext) { const f32x4 g4 = *(const f32x4*)(gnext + col); u32x2 w; w.x = cvtpk(v.x * g4.x, v.y * g4.y); w.y = cvtpk(v.z * g4.z, v.w * g4.w); *(u32x2*)(xg + off) = w; }
                    }
                ss += __shfl_xor(ss, 16); ss += __shfl_xor(ss, 32);
                if (fq == 0) ssq[(size_t)row * 16 + u.pn * 4 + wc] = ss;
            }
    }
};

DI unsigned f2bf(float f) { unsigned u = __builtin_bit_cast(unsigned, f); return (u + 0x7fffu + ((u >> 16) & 1u)) >> 16; }
DI unsigned pk2(float lo, float hi) { return f2bf(lo) | (f2bf(hi) << 16); }
DI void transpose_item(const float* W, int K, int N, bf16_t* WT, LAS float* scr, int item, int lane) {
    const int nblk = N / 32, kb = item / nblk, nb = item % nblk, k0 = 64 * kb, n0 = 32 * nb;
#pragma unroll 8
    for (int i = 0; i < 32; ++i) { const int kk = 2 * i + (lane >> 5); scr[kk * 33 + (lane & 31)] = W[(size_t)(k0 + kk) * N + n0 + (lane & 31)]; }
    asm volatile("s_waitcnt lgkmcnt(0)" ::: "memory");
    const int c = lane & 7;
#pragma unroll
    for (int j = 0; j < 4; ++j) { const int n = (lane >> 3) + 8 * j; const LAS float* s = scr + (8 * c) * 33 + n;
        u32x4 o; o.x = pk2(s[0 * 33], s[1 * 33]); o.y = pk2(s[2 * 33], s[3 * 33]); o.z = pk2(s[4 * 33], s[5 * 33]); o.w = pk2(s[6 * 33], s[7 * 33]);
        *(u32x4*)(WT + (size_t)(n0 + n) * K + k0 + 8 * c) = o; }
    asm volatile("s_waitcnt lgkmcnt(0)" ::: "memory");
}

__constant__ float ROPE_INV[16] = {1.0f, 0.44036662578582764f, 0.193922758102417f, 0.08539710193872452f, 0.03760603070259094f, 0.016560440883040428f, 0.00729266507551074f, 0.0032114461064338684f,
                                   0.001414213445968926f, 0.0006227724370546639f, 0.00027424818836152554f, 0.00012076974235242233f, 5.318296462064609e-05f, 2.3419997887685895e-05f, 1.0313385246263351e-05f, 4.541670477919979e-06f};
DI void phase_prologue(const Params& p, LAS unsigned char* lds, int tid, int wid, int lane) {
    unsigned char* ws = p.ws;
    LAS float* scr = (LAS float*)(lds + wid * 16384);
    const int gw = blockIdx.x * NWAVES + wid, NGW = gridDim.x * NWAVES;
    constexpr int I_AIN = 16 * 320, I_OUT = 16 * 32, I_BIN = 16 * 128, PER_J = I_AIN + 2 * I_OUT + I_BIN;
    for (int it = gw; it < 2 * PER_J; it += NGW) {
        const int j = it / PER_J; int r = it % PER_J;
        if (r < I_AIN) { transpose_item(p.a_w_in + (size_t)j * 1024 * 10240, 1024, 10240, (bf16_t*)(ws + WS_WA_IN) + (size_t)j * 10240 * 1024, scr, r, lane); continue; } r -= I_AIN;
        if (r < I_OUT) { transpose_item(p.a_w_out + (size_t)j * 1024 * 1024, 1024, 1024, (bf16_t*)(ws + WS_WA_OUT) + (size_t)j * 1024 * 1024, scr, r, lane); continue; } r -= I_OUT;
        if (r < I_BIN) { transpose_item(p.b_w_in + (size_t)j * 1024 * 4096, 1024, 4096, (bf16_t*)(ws + WS_WB_IN) + (size_t)j * 4096 * 1024, scr, r, lane); continue; } r -= I_BIN;
        transpose_item(p.b_w_out + (size_t)j * 1024 * 1024, 1024, 1024, (bf16_t*)(ws + WS_WB_OUT) + (size_t)j * 1024 * 1024, scr, r, lane);
    }
    bf16_t* xg = (bf16_t*)(ws + WS_XG); float* ssq = (float*)(ws + WS_SSQ);
    for (int m = gw; m < MROWS; m += NGW) {
        const f32x4* xr = (const f32x4*)(p.x + (size_t)m * DM) + lane; const f32x4* gr = (const f32x4*)p.a_norm + lane;
        float s = 0.f;
#pragma unroll
        for (int j = 0; j < 4; ++j) { const f32x4 v = xr[64 * j], g = gr[64 * j]; s += (v.x * v.x + v.y * v.y) + (v.z * v.z + v.w * v.w);
            u32x2 w; w.x = cvtpk(v.x * g.x, v.y * g.y); w.y = cvtpk(v.z * g.z, v.w * g.w); *((u32x2*)(xg + (size_t)m * DM) + lane + 64 * j) = w; }
        s = wave_sum(s);
        if (lane < 16) ssq[(size_t)m * 16 + lane] = (lane == 0) ? s : 0.f;
    }
    float* cosA = (float*)(ws + WS_ROPE); float* sinA = cosA + SEQ * 16; float* cosB = sinA + SEQ * 16; float* sinB = cosB + SEQ * 8;
    for (int idx = blockIdx.x * NTHREADS + tid; idx < SEQ * 24; idx += gridDim.x * NTHREADS) {
        int pos, i, rotd; float* cd; float* sd;
        if (idx < SEQ * 16) { pos = idx >> 4; i = idx & 15; rotd = 32; cd = cosA + idx; sd = sinA + idx; }
        else { const int k = idx - SEQ * 16; pos = k >> 3; i = k & 7; rotd = 16; cd = cosB + k; sd = sinB + k; }
        const float inv = ROPE_INV[(rotd == 32) ? i : 2 * i];
        const float ang = (float)pos * inv;
        const double rev = (double)ang * 0.15915494309189535;
        const double fr = rev - rint(rev);
        *cd = __builtin_amdgcn_cosf((float)fr); *sd = __builtin_amdgcn_sinf((float)fr);
    }
}

constexpr int AW_K = 0, AW_V = 8704, AW_BYTES = 18944;
DI void attnA_item(LAS char* wl, bf16_t* Qb, const bf16_t* Kb, const bf16_t* Vb, float* lse, int r, int rho, int c, int h, int lane, bool dry) {
    const int q = lane & 31, hh = lane >> 5, lr = lane >> 4, lc = lane & 15;
    const int tq = rho + r * (32 * c + q);
    bf16_t* Qrow = Qb + (size_t)tq * DM + h * 128;
    bf16x8 qf[8];
#pragma unroll
    for (int st = 0; st < 8; ++st) qf[st] = *(const bf16x8*)(Qrow + 16 * st + 8 * hh);
    f32x16 o[4];
#pragma unroll
    for (int db = 0; db < 4; ++db)
#pragma unroll
        for (int i = 0; i < 16; ++i) o[db][i] = 0.f;
    float m_run = NEGB, l_run = 0.f;
    const int t_lo = (c - 4 > 0) ? c - 4 : 0;
    u32x4 kreg[8], vreg[8];
    {
        const size_t tok0 = (size_t)(rho + r * (32 * t_lo + lr));
#pragma unroll
        for (int it = 0; it < 8; ++it) { const size_t off = (tok0 + (size_t)r * 4 * it) * DM + h * 128 + lc * 8; kreg[it] = *(const u32x4*)(Kb + off); vreg[it] = *(const u32x4*)(Vb + off); }
    }
    const LAS char* vb = wl + AW_V + (4 * hh + (lc >> 2)) * 320 + (lr & 1) * 32 + (lane & 3) * 8;
    for (int t = t_lo; t <= c; ++t) {
#pragma unroll
        for (int it = 0; it < 8; ++it) { *(LAS u32x4*)(wl + AW_K + (4 * it + lr) * 272 + lc * 16) = kreg[it]; *(LAS u32x4*)(wl + AW_V + (4 * it + lr) * 320 + lc * 16) = vreg[it]; }
        if (t < c) {
            const size_t tok0 = (size_t)(rho + r * (32 * (t + 1) + lr));
#pragma unroll
            for (int it = 0; it < 8; ++it) { const size_t off = (tok0 + (size_t)r * 4 * it) * DM + h * 128 + lc * 8; kreg[it] = *(const u32x4*)(Kb + off); vreg[it] = *(const u32x4*)(Vb + off); }
        }
        f32x16 s;
#pragma unroll
        for (int i = 0; i < 16; ++i) s[i] = 0.f;
#pragma unroll
        for (int st = 0; st < 8; ++st) { const bf16x8 a = *(const LAS bf16x8*)(wl + AW_K + q * 272 + st * 32 + hh * 16); s = MFMA32(a, qf[st], s); }
        if (t == c) {
#pragma unroll
            for (int i = 0; i < 16; ++i) if (crow(i, hh) > q) s[i] = NEGB;
        }
        if (t == c - 4) {
#pragma unroll
            for (int i = 0; i < 16; ++i) if (crow(i, hh) < q) s[i] = NEGB;
        }
        float mx = s[0];
#pragma unroll
        for (int i = 1; i < 16; ++i) mx = fmaxf(mx, s[i]);
        mx = fmaxf(mx, __shfl_xor(mx, 32));
        const float m_new = fmaxf(m_run, mx);
        const float alpha = fexp2(m_run - m_new);
        m_run = m_new;
        float ps = 0.f;
#pragma unroll
        for (int i = 0; i < 16; ++i) { s[i] = fexp2(s[i] - m_new); ps += s[i]; }
        l_run = l_run * alpha + ps;
#pragma unroll
        for (int db = 0; db < 4; ++db)
#pragma unroll
            for (int i = 0; i < 16; ++i) o[db][i] *= alpha;
        bf16x8 pf[2];
#pragma unroll
        for (int s2 = 0; s2 < 2; ++s2) { u32x4 w; w.x = cvtpk(s[8 * s2], s[8 * s2 + 1]); w.y = cvtpk(s[8 * s2 + 2], s[8 * s2 + 3]); w.z = cvtpk(s[8 * s2 + 4], s[8 * s2 + 5]); w.w = cvtpk(s[8 * s2 + 6], s[8 * s2 + 7]); pf[s2] = __builtin_bit_cast(bf16x8, w); }
#pragma unroll
        for (int db = 0; db < 4; ++db)
#pragma unroll
            for (int s2 = 0; s2 < 2; ++s2) {
                const s16x4 lo = vtr(vb + (16 * s2) * 320 + db * 64), hi = vtr(vb + (16 * s2 + 8) * 320 + db * 64);
                const bf16x8 a = (bf16x8){lo[0], lo[1], lo[2], lo[3], hi[0], hi[1], hi[2], hi[3]};
                o[db] = MFMA32(a, pf[s2], o[db]);
            }
    }
    const float l_tot = l_run + __shfl_xor(l_run, 32);
    const float inv = 1.0f / l_tot;
    if (dry) return;
#pragma unroll
    for (int db = 0; db < 4; ++db)
#pragma unroll
        for (int i4 = 0; i4 < 4; ++i4) {
            u32x2 w; w.x = cvtpk(o[db][4 * i4] * inv, o[db][4 * i4 + 1] * inv); w.y = cvtpk(o[db][4 * i4 + 2] * inv, o[db][4 * i4 + 3] * inv);
            *(u32x2*)(Qrow + 32 * db + 8 * i4 + 4 * hh) = w;
        }
    if (hh == 0) lse[(size_t)tq * 8 + h] = (m_run + __log2f(l_tot)) * LN2;
}

DI void phase_attnA(const Params& p, LAS unsigned char* lds, int wid, int lane, bool dry) {
    bf16_t* qkv = (bf16_t*)(p.ws + WS_QKV); float* lse = (float*)(p.ws + WS_LSE);
    LAS char* wl = (LAS char*)lds + wid * AW_BYTES;
    const int gw = blockIdx.x * NWAVES + wid, NGW = gridDim.x * NWAVES;
    for (int id = gw; id < 3 * 2048; id += NGW) {
        const int g = id >> 11, rem = id & 2047, h = rem >> 8, cc = rem & 255;
        const int r = (g == 0) ? 1 : (g == 1) ? 4 : 16;
        const int cpr = 256 / r;
        const int rho = cc / cpr, c = cc % cpr;
        bf16_t* Qb = qkv + (size_t)(g * 3 + 0) * ((size_t)SEQ * DM);
        const bf16_t* Kb = qkv + (size_t)(g * 3 + 1) * ((size_t)SEQ * DM);
        const bf16_t* Vb = qkv + (size_t)(g * 3 + 2) * ((size_t)SEQ * DM);
        attnA_item(wl, Qb, Kb, Vb, lse + (size_t)g * SEQ * 8, r, rho, c, h, lane, dry);
    }
}

DI void phase_combineA(const Params& p, int bidx, int tid) {
    const bf16_t* qkv = (const bf16_t*)(p.ws + WS_QKV); const float* lse = (const float*)(p.ws + WS_LSE);
    bf16_t* zb = (bf16_t*)(p.ws + WS_Z) + (size_t)bidx * SEQ * DM;
    for (int idx = blockIdx.x * NTHREADS + tid; idx < SEQ * 128; idx += gridDim.x * NTHREADS) {
        const int row = idx >> 7, ch = idx & 127, head = ch >> 4;
        const float l0 = lse[(size_t)row * 8 + head], l1 = lse[(size_t)(SEQ + row) * 8 + head], l2 = lse[(size_t)(2 * SEQ + row) * 8 + head];
        const float mx = fmaxf(l0, fmaxf(l1, l2));
        float e0 = __expf(l0 - mx), e1 = __expf(l1 - mx), e2 = __expf(l2 - mx);
        const float inv = 1.0f / (e0 + e1 + e2); e0 *= inv; e1 *= inv; e2 *= inv;
        const size_t off = (size_t)row * DM + ch * 8;
        const u32x4 a0 = *(const u32x4*)(qkv + off), a1 = *(const u32x4*)(qkv + (size_t)3 * SEQ * DM + off), a2 = *(const u32x4*)(qkv + (size_t)6 * SEQ * DM + off);
        const u32x4 zz = *(const u32x4*)(zb + off);
        u32x4 w;
#pragma unroll
        for (int k = 0; k < 4; ++k) {
            const float o_lo = e0 * __uint_as_float(a0[k] << 16) + e1 * __uint_as_float(a1[k] << 16) + e2 * __uint_as_float(a2[k] << 16);
            const float o_hi = e0 * __uint_as_float(a0[k] & 0xffff0000u) + e1 * __uint_as_float(a1[k] & 0xffff0000u) + e2 * __uint_as_float(a2[k] & 0xffff0000u);
            const float z_lo = __uint_as_float(zz[k] << 16), z_hi = __uint_as_float(zz[k] & 0xffff0000u);
            w[k] = cvtpk(o_lo * silu(z_lo), o_hi * silu(z_hi));
        }
        *(u32x4*)(zb + off) = w;
    }
}

constexpr int BB_SLOT = 16384, BB_VB = 3 * BB_SLOT;
constexpr float BB_THR = 8.0f;
#define SBAR() __builtin_amdgcn_sched_barrier(0)
DI void dma16(const void* sbase, unsigned voff, unsigned lds_dst) {
    unsigned keep;
    asm volatile("s_mov_b32 %0, m0\n\ts_mov_b32 m0, %3\n\ts_nop 0\n\tglobal_load_lds_dwordx4 %1, %2\n\ts_mov_b32 m0, %0" : "=&s"(keep) : "v"(voff), "s"(sbase), "s"(lds_dst) : "memory");
}
DI void attnB_unit(LAS char* lds, const bf16_t* Q, const bf16_t* K, const bf16_t* V, bf16_t* Z, const float* subln, int b, int h, int qb, float lam, float oscale, int tid, int wid, int lane, bool dry) {
    const int strm = wid >> 2, wq = wid & 3, q = lane & 31, hh = lane >> 5;
    const int q0 = qb * 128 + wq * 32;
    const size_t rowbase = (size_t)b * SEQ;
    const char* Qb = (const char*)(Q + (rowbase + q0) * DM + h * 128 + strm * 64);
    unsigned qoff = (unsigned)(q * DM + 8 * hh) * 2u; asm volatile("" : "+v"(qoff));
    bf16x8 qf[4];
#pragma unroll
    for (int st = 0; st < 4; ++st) qf[st] = *(const bf16x8*)(Qb + 32 * st + qoff);
    f32x16 o[4], negm;
#pragma unroll
    for (int db = 0; db < 4; ++db)
#pragma unroll
        for (int i = 0; i < 16; ++i) o[db][i] = 0.f;
    float mhat = 0.f, l_run = 0.f;
    const int NT = 2 * qb + 2, NTw = (q0 >> 6) + 1;
    const char* Kg = (const char*)(K + rowbase * DM + h * 128); const char* Vg = (const char*)(V + rowbase * DM + h * 128);
    const int drow = 4 * wid + (lane >> 4), dpc = lane & 15;
    unsigned voffK = (unsigned)(drow * (DM * 2) + ((dpc ^ (drow & 15)) * 16)); asm volatile("" : "+v"(voffK));
    unsigned voffV = (unsigned)(drow * (DM * 2) + ((dpc ^ ((drow & 3) << 2)) * 16)); asm volatile("" : "+v"(voffV));
    const unsigned ldsb = (unsigned)(size_t)lds;
    const unsigned dstw = ldsb + (unsigned)wid * 1024u;
#define BB_DMAK(t, slot) do { const char* b_ = Kg + (size_t)(t) * (64 * DM * 2); const unsigned d_ = (unsigned)__builtin_amdgcn_readfirstlane(dstw + (slot) * BB_SLOT); dma16(b_, voffK, d_); dma16(b_ + 32 * DM * 2, voffK, d_ + 8192u); } while (0)
#define BB_DMAV(t, slot) do { const char* b_ = Vg + (size_t)(t) * (64 * DM * 2); const unsigned d_ = (unsigned)__builtin_amdgcn_readfirstlane(dstw + BB_VB + (slot) * BB_SLOT); dma16(b_, voffV, d_); dma16(b_ + 32 * DM * 2, voffV, d_ + 8192u); } while (0)
#define BB_WAITBAR(N) asm volatile("s_waitcnt vmcnt(" #N ") lgkmcnt(0)\n\ts_barrier" ::: "memory")
    const int kp0 = ((strm * 8 + hh) ^ (q & 15)) * 16;
    int kq0 = q * 256 + kp0, kq1 = q * 256 + (kp0 ^ 32), kq2 = q * 256 + (kp0 ^ 64), kq3 = q * 256 + (kp0 ^ 96);
    asm volatile("" : "+v"(kq0), "+v"(kq1), "+v"(kq2), "+v"(kq3));
    const int q4 = (lane & 15) >> 2, vrest = (4 * hh + q4) * 256 + ((lane >> 4) & 1) * 32 + ((lane & 3) >> 1) * 16 + (lane & 1) * 8;
    int vq0 = BB_VB + vrest + ((0 ^ q4) * 64), vq1 = BB_VB + vrest + ((1 ^ q4) * 64), vq2 = BB_VB + vrest + ((2 ^ q4) * 64), vq3 = BB_VB + vrest + ((3 ^ q4) * 64);
    asm volatile("" : "+v"(vq0), "+v"(vq1), "+v"(vq2), "+v"(vq3));
#define BB_MASK(P0, P1, t) do { int qh_ = q0 + q - 64 * (t) - 4 * hh; asm volatile("" : "+v"(qh_));   \
        _Pragma("unroll") for (int i = 0; i < 16; ++i) { const int c_ = (i & 3) + 8 * (i >> 2); if (c_ > qh_) P0[i] = NEGB; if (c_ + 32 > qh_) P1[i] = NEGB; } } while (0)
#define BB_ROWMAX(P0, P1, rm) do { float a_ = max3_s(P0[0], P0[1], P1[0]), b_ = max3_s(P0[2], P0[3], P1[1]); a_ = max3_s(a_, P1[2], P1[3]); \
        _Pragma("unroll") for (int r = 4; r < 16; r += 4) { a_ = max3_s(a_, P0[r], P0[r + 1]); b_ = max3_s(b_, P0[r + 2], P0[r + 3]); a_ = max3_s(a_, P1[r], P1[r + 1]); b_ = max3_s(b_, P1[r + 2], P1[r + 3]); } \
        rm = fmaxf(a_, b_); { const auto rr_ = __builtin_amdgcn_permlane32_swap(__float_as_uint(rm), __float_as_uint(rm), false, false); rm = fmaxf(__uint_as_float(rr_[0]), __uint_as_float(rr_[1])); } } while (0)
#define BB_EXP1(P, B) do { P[B] = fexp2(P[B]); } while (0)
#define BB_EXP2(P, B) do { P[B] = fexp2(P[B]); P[B + 1] = fexp2(P[B + 1]); } while (0)
#define BB_EXP4(P, B) do { P[B] = fexp2(P[B] - mhat); P[B + 1] = fexp2(P[B + 1] - mhat); P[B + 2] = fexp2(P[B + 2] - mhat); P[B + 3] = fexp2(P[B + 3] - mhat); } while (0)
#define BB_PACK(P, B) (u32x4){cvtpk(P[B], P[B + 1]), cvtpk(P[B + 2], P[B + 3]), cvtpk(P[B + 4], P[B + 5]), cvtpk(P[B + 6], P[B + 7])}
#define BB_KRD(KQ, ROWS) (*(const LAS bf16x8*)(lds + ks_ + (KQ) + (ROWS) * 256))
#define BB_VRD(L, H, S2, DB) do { L = vtr(lds + vs_ + vq##DB + (16 * (S2)) * 256); H = vtr(lds + vs_ + vq##DB + (16 * (S2) + 8) * 256); } while (0)
#define BB_PVM(PF, DB, L, H, A0, A1) do { o[DB] = MFMA32(((bf16x8){L[0], L[1], L[2], L[3], H[0], H[1], H[2], H[3]}), __builtin_bit_cast(bf16x8, PF), o[DB]); sacc_ = fadd_s(sacc_, fadd_s((A0), (A1))); SBAR(); } while (0)
#define BB_PVALL(C0, C1) do { s16x4 la_, ha_, lb_, hb_, lc_, hc_; u32x4 pf_; \
        BB_VRD(la_, ha_, 0, 0); BB_VRD(lb_, hb_, 0, 1); \
        pf_ = BB_PACK(C0, 0); BB_VRD(lc_, hc_, 0, 2); BB_EXP1(C1, 8); BB_PVM(pf_, 0, la_, ha_, C0[0], C0[1]); \
        BB_VRD(la_, ha_, 0, 3); BB_EXP1(C1, 9); BB_PVM(pf_, 1, lb_, hb_, C0[2], C0[3]); \
        BB_VRD(lb_, hb_, 1, 0); BB_EXP1(C1, 10); BB_PVM(pf_, 2, lc_, hc_, C0[4], C0[5]); \
        BB_VRD(lc_, hc_, 1, 1); BB_EXP1(C1, 11); BB_PVM(pf_, 3, la_, ha_, C0[6], C0[7]); \
        pf_ = BB_PACK(C0, 8); BB_VRD(la_, ha_, 1, 2); BB_EXP1(C1, 12); BB_PVM(pf_, 0, lb_, hb_, C0[8], C0[9]); \
        BB_VRD(lb_, hb_, 1, 3); BB_EXP1(C1, 13); BB_PVM(pf_, 1, lc_, hc_, C0[10], C0[11]); \
        BB_VRD(lc_, hc_, 2, 0); BB_EXP1(C1, 14); BB_PVM(pf_, 2, la_, ha_, C0[12], C0[13]); \
        BB_VRD(la_, ha_, 2, 1); BB_EXP1(C1, 15); BB_PVM(pf_, 3, lb_, hb_, C0[14], C0[15]); \
        pf_ = BB_PACK(C1, 0); BB_VRD(lb_, hb_, 2, 2); BB_PVM(pf_, 0, lc_, hc_, C1[0], C1[1]); \
        BB_VRD(lc_, hc_, 2, 3); BB_PVM(pf_, 1, la_, ha_, C1[2], C1[3]); \
        BB_VRD(la_, ha_, 3, 0); BB_PVM(pf_, 2, lb_, hb_, C1[4], C1[5]); \
        BB_VRD(lb_, hb_, 3, 1); BB_PVM(pf_, 3, lc_, hc_, C1[6], C1[7]); \
        pf_ = BB_PACK(C1, 8); BB_VRD(lc_, hc_, 3, 2); BB_PVM(pf_, 0, la_, ha_, C1[8], C1[9]); \
        BB_VRD(la_, ha_, 3, 3); BB_PVM(pf_, 1, lb_, hb_, C1[10], C1[11]); \
        BB_PVM(pf_, 2, lc_, hc_, C1[12], C1[13]); \
        BB_PVM(pf_, 3, la_, ha_, C1[14], C1[15]); \
    } while (0)
#define BB_STEP(C0, C1, N0, N1, T) do { \
        const int t_ = (T); \
        if (t_ + 3 < NT) BB_DMAK(t_ + 3, sl0); \
        if (t_ + 2 < NT) BB_DMAV(t_ + 2, sl2); \
        if (t_ < NTw) { \
            if (t_ > 0) { \
                if (t_ == NTw - 1) BB_MASK(C0, C1, t_); \
                float rm_; BB_ROWMAX(C0, C1, rm_); \
                if (__any(rm_ > BB_THR)) { const float dl_ = fmaxf(rm_, 0.f); mhat += dl_; \
                    _Pragma("unroll") for (int i = 0; i < 16; ++i) { C0[i] -= dl_; C1[i] -= dl_; negm[i] = -mhat; } \
                    const float f_ = fexp2(-dl_); l_run *= f_; \
                    _Pragma("unroll") for (int db = 0; db < 4; ++db) _Pragma("unroll") for (int i = 0; i < 16; ++i) o[db][i] *= f_; } \
            } \
            {   \
                const int ks_ = sl1 * BB_SLOT; \
                bf16x8 fa_ = BB_KRD(kq0, 0), fb_ = BB_KRD(kq0, 32), fc_ = BB_KRD(kq1, 0); \
                SBAR(); \
                N0 = MFMA32(fa_, qf[0], negm); BB_EXP2(C0, 0); BB_EXP1(C1, 0);  fa_ = BB_KRD(kq1, 32); SBAR(); \
                N1 = MFMA32(fb_, qf[0], negm); BB_EXP2(C0, 2); BB_EXP1(C1, 1);  fb_ = BB_KRD(kq2, 0); SBAR(); \
                N0 = MFMA32(fc_, qf[1], N0);   BB_EXP2(C0, 4); BB_EXP1(C1, 2);  fc_ = BB_KRD(kq2, 32); SBAR(); \
                N1 = MFMA32(fa_, qf[1], N1);   BB_EXP2(C0, 6); BB_EXP1(C1, 3);  fa_ = BB_KRD(kq3, 0); SBAR(); \
                N0 = MFMA32(fb_, qf[2], N0);   BB_EXP2(C0, 8); BB_EXP1(C1, 4);  fb_ = BB_KRD(kq3, 32); SBAR(); \
                N1 = MFMA32(fc_, qf[2], N1);   BB_EXP2(C0, 10); BB_EXP1(C1, 5); SBAR(); \
                N0 = MFMA32(fa_, qf[3], N0);   BB_EXP2(C0, 12); BB_EXP1(C1, 6); SBAR(); \
                N1 = MFMA32(fb_, qf[3], N1);   BB_EXP2(C0, 14); BB_EXP1(C1, 7); SBAR(); \
            } \
            const int vs_ = sl0 * BB_SLOT; float sacc_ = 0.f; \
            BB_PVALL(C0, C1); \
            l_run += sacc_; \
        } \
          \
        if (t_ + 3 < NT) BB_WAITBAR(4); else if (t_ + 2 < NT) BB_WAITBAR(2); else BB_WAITBAR(0); \
        { const int s_ = sl0; sl0 = sl1; sl1 = sl2; sl2 = s_; } \
    } while (0)
    int sl0 = 0, sl1 = 1, sl2 = 2;
    BB_DMAK(0, 0); BB_DMAV(0, 0); BB_DMAK(1, 1); BB_DMAV(1, 1); if (NT > 2) BB_DMAK(2, 2);
    BB_WAITBAR(0);
    f32x16 pA0, pA1, pB0, pB1;
    {
        const int ks_ = 0;
#pragma unroll
        for (int i = 0; i < 16; ++i) { pA0[i] = 0.f; pA1[i] = 0.f; pB0[i] = 0.f; pB1[i] = 0.f; }
        pA0 = MFMA32(BB_KRD(kq0, 0), qf[0], pA0); pA1 = MFMA32(BB_KRD(kq0, 32), qf[0], pA1);
        pA0 = MFMA32(BB_KRD(kq1, 0), qf[1], pA0); pA1 = MFMA32(BB_KRD(kq1, 32), qf[1], pA1);
        pA0 = MFMA32(BB_KRD(kq2, 0), qf[2], pA0); pA1 = MFMA32(BB_KRD(kq2, 32), qf[2], pA1);
        pA0 = MFMA32(BB_KRD(kq3, 0), qf[3], pA0); pA1 = MFMA32(BB_KRD(kq3, 32), qf[3], pA1);
        asm volatile("s_nop 15\n\ts_nop 7" : "+v"(pA0), "+v"(pA1));
        if (NTw == 1) BB_MASK(pA0, pA1, 0);
        float rm; BB_ROWMAX(pA0, pA1, rm);
        mhat = rm;
#pragma unroll
        for (int i = 0; i < 16; ++i) { pA0[i] -= rm; pA1[i] -= rm; negm[i] = -rm; }
    }
    BB_WAITBAR(0);
#pragma unroll 1
    for (int t = 0; t < NT; t += 2) {
        BB_STEP(pA0, pA1, pB0, pB1, t);
        BB_STEP(pB0, pB1, pA0, pA1, t + 1);
    }
#undef BB_DMAK
#undef BB_DMAV
#undef BB_WAITBAR
#undef BB_MASK
#undef BB_ROWMAX
#undef BB_EXP4
#undef BB_EXP2
#undef BB_EXP1
#undef BB_PACK
#undef BB_KRD
#undef BB_VRD
#undef BB_PVM
#undef BB_PVALL
#undef BB_STEP
    const float l_tot = l_run + __shfl_xor(l_run, 32);
    const float inv = 1.0f / l_tot;
    LAS float* ex = (LAS float*)lds + wq * 4096;
    if (strm == 1) {
#pragma unroll
        for (int db = 0; db < 4; ++db)
#pragma unroll
            for (int i = 0; i < 16; ++i) ex[(db * 16 + i) * 64 + lane] = o[db][i] * inv;
    }
    __syncthreads();
    if (strm == 0) {
        float ss = 0.f;
#pragma unroll
        for (int db = 0; db < 4; ++db) {
#pragma unroll
            for (int i = 0; i < 16; ++i) { const float d = o[db][i] * inv - lam * ex[(db * 16 + i) * 64 + lane]; o[db][i] = d; ss += d * d; }
            __builtin_amdgcn_sched_barrier(0); }
        ss += __shfl_xor(ss, 32);
        const float rn = (1.0f / sqrtf(ss * (1.0f / 128.0f) + EPS)) * oscale;
        char* Zb = (char*)(Z + (rowbase + q0) * DM + h * 128);
        asm volatile("" : "+s"(subln));
        unsigned zoff = (unsigned)(q * DM + 4 * hh) * 2u; asm volatile("" : "+v"(zoff));
#pragma unroll
        for (int db = 0; db < 4; ++db)
#pragma unroll
            for (int i4 = 0; i4 < 4; ++i4) {
                const int d0 = 32 * db + 8 * i4 + 4 * hh;
                const u32x2 zz = *(const u32x2*)(Zb + (32 * db + 8 * i4) * 2 + zoff);
                const f32x4 sl = *(const f32x4*)(subln + d0);
                const float z0 = __uint_as_float(zz.x << 16), z1 = __uint_as_float(zz.x & 0xffff0000u), z2 = __uint_as_float(zz.y << 16), z3 = __uint_as_float(zz.y & 0xffff0000u);
                u32x2 w; w.x = cvtpk(o[db][4 * i4] * rn * sl.x * silu(z0), o[db][4 * i4 + 1] * rn * sl.y * silu(z1));
                w.y = cvtpk(o[db][4 * i4 + 2] * rn * sl.z * silu(z2), o[db][4 * i4 + 3] * rn * sl.w * silu(z3));
                if (!dry) *(u32x2*)(Zb + (32 * db + 8 * i4) * 2 + zoff) = w;
                __builtin_amdgcn_sched_barrier(0);
            }
    }
    __syncthreads();
}

DI void phase_attnB(const Params& p, LAS unsigned char* lds, int j, int layer, int tid, int wid, int lane, bool dry) {
    const bf16_t* Q = (const bf16_t*)(p.ws + WS_QKV); const bf16_t* K = Q + (size_t)MROWS * DM; const bf16_t* V = K + (size_t)MROWS * DM;
    bf16_t* Z = (bf16_t*)(p.ws + WS_Z);
    const float* lp = p.b_lambda + j * 256;
    const float d1 = wave_sum(lp[lane] * lp[64 + lane]), d2 = wave_sum(lp[128 + lane] * lp[192 + lane]);
    asm volatile("" : "+s"(layer));
    const float lam_init = (layer == 1) ? 0.35550906759096926f : 0.5560582041556006f;
    const float lam = expf(d1) - expf(d2) + lam_init;
    const float oscale = 1.0f - lam_init;
    const float* subln = p.b_subln + j * 128;
    const int G8 = gridDim.x >> 3;
    for (int v0 = blockIdx.x; v0 < 256; v0 += gridDim.x) {
        const int v = ((gridDim.x & 7) == 0) ? (v0 & 7) * G8 + (v0 >> 3) : v0;
        const int bh = v >> 4, s = v & 15;
#pragma unroll 1
        for (int k = 0; k < 4; ++k) {
            const int qb = (k == 0) ? 63 - s : (k == 1) ? 32 + s : (k == 2) ? 31 - s : s;
            attnB_unit((LAS char*)lds, Q, K, V, Z, subln, bh >> 3, bh & 7, qb, lam, oscale, tid, wid, lane, dry);
        }
    }
}

DI void phase_final(const Params& p, int wid, int lane) {
    const int gw = blockIdx.x * NWAVES + wid, NGW = gridDim.x * NWAVES;
    for (int m = gw; m < MROWS; m += NGW) {
        f32x4* xr = (f32x4*)(p.out + (size_t)m * DM) + lane; const f32x4* gr = (const f32x4*)p.final_norm + lane;
        f32x4 v[4]; float s = 0.f;
#pragma unroll
        for (int j = 0; j < 4; ++j) { v[j] = xr[64 * j]; s += (v[j].x * v[j].x + v[j].y * v[j].y) + (v[j].z * v[j].z + v[j].w * v[j].w); }
        const float rs = 1.0f / sqrtf(wave_sum(s) * (1.0f / DM) + EPS);
#pragma unroll
        for (int j = 0; j < 4; ++j) xr[64 * j] = v[j] * rs * gr[64 * j];
    }
}

#define XB_TMO      128
#define XB_XCNT(j)  (256  + 64 * (j))
#define XB_XSUB(j)  (1280 + 64 * (j))
#define XB_XGEN(j)  (2304 + 64 * (j))
#define XB_TOP      3328
#define XB_TOPGEN   3392
#define XCD_BAR_WORDS 3456
#define XB_SPIN_CAP (1u << 18)

__device__ __forceinline__ unsigned xb_ld(unsigned* p)              { return __hip_atomic_load(p, __ATOMIC_RELAXED, __HIP_MEMORY_SCOPE_AGENT); }
__device__ __forceinline__ unsigned xb_add(unsigned* p, unsigned v) { return __hip_atomic_fetch_add(p, v, __ATOMIC_RELAXED, __HIP_MEMORY_SCOPE_AGENT); }
__device__ __forceinline__ unsigned xb_xcc_id() { return (unsigned)__builtin_amdgcn_s_getreg((3 << 11) | 20) & 0xFu; }
#define XB_SPIN(cond, bar) do { unsigned _sp = 0; while (cond) { __builtin_amdgcn_s_sleep(1); \
    if ((++_sp & 255u) == 0u) { if (xb_ld(&(bar)[XB_TMO])) break; if (_sp > XB_SPIN_CAP) { atomicAdd(&(bar)[XB_TMO], 1u); break; } } } } while (0)

struct XcdBarrier {
    unsigned* bar; unsigned x;
    volatile LAS unsigned* st;
};

__device__ __forceinline__ XcdBarrier xcd_barrier_post(unsigned* bar, volatile LAS unsigned* st) {
    XcdBarrier b; b.bar = bar; b.x = xb_xcc_id(); b.st = st;
    if (threadIdx.x == 0) (void)xb_add(&bar[XB_XCNT(b.x)], 1u);
    return b;
}
__device__ __forceinline__ void xcd_barrier_complete(unsigned* bar, unsigned x, unsigned& nloc, unsigned& nx) {
    const unsigned G = gridDim.x * gridDim.y * gridDim.z;
    unsigned sum, cnt, mine, sp = 0u;
    for (;;) {
        sum = 0u; cnt = 0u; mine = 0u;
#pragma unroll
        for (unsigned j = 0; j < 16; ++j) { const unsigned c = xb_ld(&bar[XB_XCNT(j)]); sum += c; cnt += (c > 0u) ? 1u : 0u; mine = (j == x) ? c : mine; }
        if (sum == G) break;
        __builtin_amdgcn_s_sleep(1);
        if ((++sp & 255u) == 0u) { if (xb_ld(&bar[XB_TMO])) break; if (sp > XB_SPIN_CAP) { atomicAdd(&bar[XB_TMO], 1u); break; } }
    }
    nloc = mine > 0u ? mine : 1u; nx = cnt > 0u ? cnt : 1u;
}

__device__ __forceinline__ void xcd_barrier(const XcdBarrier& b) {
    asm volatile("s_waitcnt vmcnt(0)" ::: "memory");
    __syncthreads();
    if (threadIdx.x == 0) {
        unsigned* bar = b.bar;
        __builtin_amdgcn_s_waitcnt(0);
        unsigned nloc = b.st[0], nx = b.st[1];
        if (nloc == 0u) { xcd_barrier_complete(bar, b.x, nloc, nx); b.st[0] = nloc; b.st[1] = nx; }
        const unsigned old = xb_add(&bar[XB_XSUB(b.x)], 1u);
        const unsigned gen = old / nloc;
        if (old + 1u == (gen + 1u) * nloc) {
            __builtin_amdgcn_fence(__ATOMIC_RELEASE, "agent");
            asm volatile("s_waitcnt vmcnt(0)" ::: "memory");
            const unsigned og = xb_add(&bar[XB_TOP], 1u);
            const unsigned tg = og / nx;
            if (og + 1u == (tg + 1u) * nx) xb_add(&bar[XB_TOPGEN], 1u);
            else XB_SPIN(xb_ld(&bar[XB_TOPGEN]) == tg, bar);
            __builtin_amdgcn_fence(__ATOMIC_ACQUIRE, "agent");
            xb_add(&bar[XB_XGEN(b.x)], 1u);
            asm volatile("s_waitcnt vmcnt(0)" ::: "memory");
        } else {
            XB_SPIN(xb_ld(&bar[XB_XGEN(b.x)]) == gen, bar);
            __builtin_amdgcn_fence(__ATOMIC_ACQUIRE, "agent");
            asm volatile("s_waitcnt vmcnt(0)" ::: "memory");
        }
    }
    __syncthreads();
}

#ifndef PROBE_KIND
#define PROBE_KIND -1
#endif
__global__ void __launch_bounds__(NTHREADS, 2) fwd_megakernel(Params p_arg) {
    extern __shared__ __attribute__((aligned(16))) unsigned char lds_raw[];
    LAS unsigned char* lds = (LAS unsigned char*)lds_raw;
    cg::grid_group grid = cg::this_grid();
    const int lo = p_arg.ph_lo, hi = p_arg.ph_hi;
    volatile LAS unsigned* bst = (volatile LAS unsigned*)(lds + LDS_BYTES - 64);
    unsigned* barw = (unsigned*)(p_arg.ws + WS_BAR);
    if (threadIdx.x == 0) { bst[0] = 0u; bst[1] = 0u; }
    if (blockIdx.x == 0) for (int i = threadIdx.x; i < XCD_BAR_WORDS; i += NTHREADS) barw[i] = 0u;
    __syncthreads();
    XcdBarrier xb; xb.bar = barw; xb.x = 0; xb.st = bst;
#pragma unroll 1
    for (int ph = lo; ph < hi; ++ph) {
        int kind;
        if (ph == 0) kind = 0; else if (ph == 21) kind = 7; else { const int r_ = (ph - 1) % 10; kind = (r_ < 6) ? 1 + r_ % 3 : (r_ == 7) ? 4 : (r_ == 8) ? 5 : 6; }
        const int reps = (kind == PROBE_KIND) ? 2 : 1;
#pragma unroll 1
        for (int rep = 0; rep < reps; ++rep) {
        int tid = threadIdx.x; asm volatile("" : "+v"(tid));
#if defined(__HIP_DEVICE_COMPILE__)
        const __attribute__((address_space(4))) Params* pp = (const __attribute__((address_space(4))) Params*)__builtin_amdgcn_kernarg_segment_ptr();
        asm volatile("" : "+s"(pp));
        const Params p = *pp;
#else
        const Params p = p_arg;
#endif
        const int lane = tid & 63, wid = __builtin_amdgcn_readfirstlane(tid >> 6);
        unsigned char* ws = p.ws;
        bf16_t* XG = (bf16_t*)(ws + WS_XG); bf16_t* Zb = (bf16_t*)(ws + WS_Z); bf16_t* QKV = (bf16_t*)(ws + WS_QKV);
        float* SSQ = (float*)(ws + WS_SSQ);
        const float* cosA = (const float*)(ws + WS_ROPE); const float* sinA = cosA + SEQ * 16; const float* cosB = sinA + SEQ * 16; const float* sinB = cosB + SEQ * 8;
        const bool dry = (PROBE_KIND >= 0) && (rep + 1 < reps) && (p.ph_hi < 1000);
        if (ph == 0) phase_prologue(p, lds, tid, wid, lane);
        else if (ph == 21) phase_final(p, wid, lane);
        else {
            const int k = ph - 1, pair = k / 10, r = k % 10;
            if (r < 6) {
                const int bidx = r / 3, s = r % 3;
                if (s == 0) {
                    pg8::Gemm g{XG + (size_t)bidx * SEQ * DM, (const bf16_t*)(ws + WS_WA_IN) + (size_t)pair * 10240 * 1024, SEQ, 10240, DM};
                    pg8::StaticOrder S; S.init(SEQ, 10240, gridDim.x, blockIdx.x);
                    EpiInA E{QKV, Zb + (size_t)bidx * SEQ * DM, SSQ + (size_t)bidx * SEQ * 16, cosA, sinA, 0.08838834764831845f * LOG2E};
                    pg8::gemm_phase<EpiInA, pg8::StaticOrder, true, true>(lds, g, S, E, tid);
                } else if (s == 1) phase_attnA(p, lds, wid, lane, dry);
                else phase_combineA(p, bidx, tid);
            } else if (r == 7) {
                pg8::Gemm g{XG, (const bf16_t*)(ws + WS_WB_IN) + (size_t)pair * 4096 * 1024, MROWS, 4096, DM};
                pg8::StaticOrder S; S.init(MROWS, 4096, gridDim.x, blockIdx.x);
                EpiInB E{QKV, Zb, SSQ, cosB, sinB, 0.125f * LOG2E};
                pg8::gemm_phase<EpiInB, pg8::StaticOrder, true, true>(lds, g, S, E, tid);
            } else if (r == 8) phase_attnB(p, lds, pair, 2 * pair + 1, tid, wid, lane, dry);
            else {
                const bool isA = (r == 6);
                const int layer = 2 * pair + (isA ? 0 : 1);
                const bf16_t* Wt = (const bf16_t*)(ws + (isA ? WS_WA_OUT : WS_WB_OUT)) + (size_t)pair * 1024 * 1024;
                const float* gnext = isA ? p.b_norm + pair * DM : (layer == 3 ? (const float*)nullptr : p.a_norm + (pair + 1) * DM);
                pg8::Gemm g{Zb, Wt, MROWS, DM, DM};
                pg8::StaticOrder S; S.init(MROWS, DM, gridDim.x, blockIdx.x);
                EpiOut E{(layer == 0) ? p.x : (const float*)p.out, p.out, XG, gnext, SSQ};
                pg8::gemm_phase<EpiOut, pg8::StaticOrder, true, true>(lds, g, S, E, tid);
            }
        }
        }
        if (ph + 1 < hi) { if (ph == lo) { grid.sync(); xb = xcd_barrier_post(barw, bst); } else xcd_barrier(xb); }
    }
}

constexpr int N_PHASES = 22;
#ifndef MK_PER_PHASE
#define MK_PER_PHASE 0
#endif

extern "C" void kernel_launch(void* const* d_in, const int* in_sizes, int n_in, void* d_out, int out_size, void* d_ws, size_t ws_size, hipStream_t stream) {
    static int grid = 0;
    if (grid == 0) {
        int dev = 0, cus = 0, per_cu = 0;
        hipGetDevice(&dev);
        hipDeviceGetAttribute(&cus, hipDeviceAttributeMultiprocessorCount, dev);
        hipFuncSetAttribute((const void*)fwd_megakernel, hipFuncAttributeMaxDynamicSharedMemorySize, LDS_BYTES);
        hipOccupancyMaxActiveBlocksPerMultiprocessor(&per_cu, (const void*)fwd_megakernel, NTHREADS, LDS_BYTES);
        if (per_cu < 1) { fprintf(stderr, "kernel_launch: occupancy query says %d blocks per CU\n", per_cu); per_cu = 1; }
        (void)hipGetLastError();
        grid = cus * 1;
        if (ws_size < WS_END) { fprintf(stderr, "kernel_launch: workspace too small (%zu < %zu)\n", ws_size, (size_t)WS_END); grid = -1; }
    }
    if (grid < 0) return;
    Params p{};
    p.x = (const float*)d_in[0]; p.a_norm = (const float*)d_in[1]; p.a_w_in = (const float*)d_in[2]; p.a_w_out = (const float*)d_in[3];
    p.b_norm = (const float*)d_in[4]; p.b_w_in = (const float*)d_in[5]; p.b_lambda = (const float*)d_in[6]; p.b_subln = (const float*)d_in[7];
    p.b_w_out = (const float*)d_in[8]; p.final_norm = (const float*)d_in[9];
    p.out = (float*)d_out; p.ws = (unsigned char*)d_ws;
#if MK_PER_PHASE
    for (int ph = 0; ph < N_PHASES; ++ph) {
        p.ph_lo = ph; p.ph_hi = ph + 1;
        hipLaunchKernelGGL(fwd_megakernel, dim3(grid), dim3(NTHREADS), LDS_BYTES, stream, p);
    }
#else
    p.ph_lo = 0; p.ph_hi = N_PHASES;
    void* args[] = {&p};
    hipError_t e = hipLaunchCooperativeKernel((const void*)fwd_megakernel, dim3(grid), dim3(NTHREADS), args, LDS_BYTES, stream);
    if (e != hipSuccess) fprintf(stderr, "cooperative launch failed: %s (grid %d)\n", hipGetErrorString(e), grid);
#endif
}
```
